# Optimizing an MI355X kernel written in HIP

```python
import math
import jax, jax.numpy as jnp
from jax import lax
import numpy as np

D_MODEL = 4096
BATCH = 2
SEQ = 4096
DEPTH = 1

CHUNK = 64

SSD_EXPAND = 2
D_INNER = SSD_EXPAND * D_MODEL
SSD_HEAD_DIM = 64
SSD_HEADS = D_INNER // SSD_HEAD_DIM
SSD_STATE = 128
SSD_GROUPS = 8
SSD_HEADS_PER_GROUP = SSD_HEADS // SSD_GROUPS
SSD_CONV = 4
SSD_CONV_DIM = D_INNER + 2 * SSD_GROUPS * SSD_STATE

FOX_HEAD_DIM = 128
FOX_HEADS = D_MODEL // FOX_HEAD_DIM
D_ATT = FOX_HEADS * FOX_HEAD_DIM
Q_BLOCK = 128

D_FF = ((8 * D_MODEL // 3 + 255) // 256) * 256
FFN_CONV = 3

ALPHA = (2.0 * DEPTH) ** 0.25
BETA = (8.0 * DEPTH) ** -0.25
LN_EPS = 1e-5
RMS_EPS = 1e-5

IN_SIZES = (D_INNER, SSD_CONV_DIM, SSD_HEADS, D_ATT, D_ATT, D_ATT, FOX_HEADS, D_MODEL, D_MODEL)
D_IN_PROJ = sum(IN_SIZES)
IN_SPLITS = tuple(int(s) for s in np.cumsum(IN_SIZES)[:-1])

kernel_name = "hybrid_ssd_fox_convffn_deepnorm"


def _layer_norm(x, g, b):
    xf = x.astype(jnp.float32)
    mu = jnp.mean(xf, axis=-1, keepdims=True)
    xc = xf - mu
    var = jnp.mean(xc * xc, axis=-1, keepdims=True)
    out = xc * lax.rsqrt(var + LN_EPS) * g.astype(jnp.float32) + b.astype(jnp.float32)
    return out.astype(x.dtype)


def _causal_dwconv(x, w, b):
    k_width = w.shape[0]
    length = x.shape[1]
    xp = jnp.pad(x, ((0, 0), (k_width - 1, 0), (0, 0)))
    out = b
    for k in range(k_width):
        out = out + w[k] * xp[:, k:k + length]
    return out


def _ssd_branch(z, xbc, dt_raw, conv_w, conv_b, dt_bias, a_log, d_skip, norm_w):
    bsz, length, _ = z.shape
    nc = length // CHUNK
    G, R, P, N = SSD_GROUPS, SSD_HEADS_PER_GROUP, SSD_HEAD_DIM, SSD_STATE
    f32 = jnp.float32
    xbc = jax.nn.silu(_causal_dwconv(xbc, conv_w, conv_b))
    xs, bm, cm = jnp.split(xbc, [D_INNER, D_INNER + G * N], axis=-1)
    xs = xs.astype(f32).reshape(bsz, length, G, R, P)
    bm = bm.astype(f32).reshape(bsz, nc, CHUNK, G, N)
    cm = cm.astype(f32).reshape(bsz, nc, CHUNK, G, N)
    dt = jax.nn.softplus(dt_raw.astype(f32) + dt_bias.astype(f32)).reshape(bsz, length, G, R)
    a = -jnp.exp(a_log.astype(f32)).reshape(G, R)
    da = (dt * a).reshape(bsz, nc, CHUNK, G, R)
    xdt = (xs * dt[..., None]).reshape(bsz, nc, CHUNK, G, R, P)
    acs = jnp.cumsum(da, axis=2)
    seg = acs[:, :, :, None] - acs[:, :, None, :]
    tri = jnp.tril(jnp.ones((CHUNK, CHUNK), dtype=bool))[None, None, :, :, None, None]
    lmat = jnp.exp(jnp.where(tri, seg, -jnp.inf))
    cb = jnp.einsum("bclgn,bcsgn->bclsg", cm, bm)
    y_diag = jnp.einsum("bclsg,bclsgr,bcsgrp->bclgrp", cb, lmat, xdt)
    decay_to_end = jnp.exp(acs[:, :, -1:] - acs)
    states = jnp.einsum("bcsgn,bcsgr,bcsgrp->bcgrpn", bm, decay_to_end, xdt)
    chunk_decay = jnp.exp(acs[:, :, -1])

    def step(h, inp):
        s_c, d_c = inp
        return d_c[..., None, None] * h + s_c, h

    h0 = jnp.zeros((bsz, G, R, P, N), f32)
    _, prev = lax.scan(step, h0, (jnp.moveaxis(states, 1, 0), jnp.moveaxis(chunk_decay, 1, 0)))
    prev = jnp.moveaxis(prev, 0, 1)
    y_off = jnp.einsum("bclgn,bcgrpn,bclgr->bclgrp", cm, prev, jnp.exp(acs))
    y = (y_diag + y_off).reshape(bsz, length, G, R, P) + d_skip.astype(f32).reshape(G, R)[..., None] * xs
    y = y.reshape(bsz, length, D_INNER) * jax.nn.silu(z.astype(f32))
    yg = y.reshape(bsz, length, G, D_INNER // G)
    yg = yg * lax.rsqrt(jnp.mean(yg * yg, axis=-1, keepdims=True) + RMS_EPS)
    return (yg.reshape(bsz, length, D_INNER) * norm_w.astype(f32)).astype(z.dtype)


def _fox_branch(q, k, v, f_logit):
    bsz, length, _ = q.shape
    H, Dh = FOX_HEADS, FOX_HEAD_DIM
    scale = 1.0 / math.sqrt(Dh)
    q = q.reshape(bsz, length, H, Dh).transpose(0, 2, 1, 3)
    k = k.reshape(bsz, length, H, Dh).transpose(0, 2, 1, 3)
    v = v.reshape(bsz, length, H, Dh).transpose(0, 2, 1, 3)
    logf = jax.nn.log_sigmoid(f_logit.astype(jnp.float32))
    fcum = jnp.cumsum(logf, axis=1).transpose(0, 2, 1)
    outs = []
    for i in range(length // Q_BLOCK):
        lo, hi = i * Q_BLOCK, (i + 1) * Q_BLOCK
        s = jnp.einsum("bhqd,bhkd->bhqk", q[:, :, lo:hi], k[:, :, :hi],
                       preferred_element_type=jnp.float32) * scale
        s = s + fcum[:, :, lo:hi, None] - fcum[:, :, None, :hi]
        mask = (lo + jnp.arange(Q_BLOCK))[:, None] >= jnp.arange(hi)[None, :]
        p = jax.nn.softmax(jnp.where(mask, s, -jnp.inf), axis=-1)
        outs.append(jnp.einsum("bhqk,bhkd->bhqd", p.astype(v.dtype), v[:, :, :hi]))
    o = jnp.concatenate(outs, axis=2)
    return o.transpose(0, 2, 1, 3).reshape(bsz, length, D_ATT)


def setup_inputs(seed: int = 0) -> dict:
    key = jax.random.key(seed)
    ks = jax.random.split(key, 24)
    f32 = jnp.float32

    def nrm(k, shape, scale):
        return scale * jax.random.normal(k, shape, f32)

    dt0 = jnp.exp(jax.random.uniform(ks[4], (DEPTH, SSD_HEADS), f32,
                                     minval=math.log(1e-3), maxval=math.log(1e-1)))
    dt_bias = dt0 + jnp.log(-jnp.expm1(-dt0))
    a_log = jnp.log(jax.random.uniform(ks[5], (DEPTH, SSD_HEADS), f32, minval=1.0, maxval=16.0))
    return {
        "x": nrm(ks[0], (BATCH, SEQ, D_MODEL), 1.0),
        "w_in": nrm(ks[1], (DEPTH, D_MODEL, D_IN_PROJ), D_MODEL ** -0.5),
        "ssd_conv_w": nrm(ks[2], (DEPTH, SSD_CONV, SSD_CONV_DIM), SSD_CONV ** -0.5),
        "ssd_conv_b": nrm(ks[3], (DEPTH, SSD_CONV_DIM), 0.01),
        "ssd_dt_bias": dt_bias,
        "ssd_a_log": a_log,
        "ssd_d": 1.0 + nrm(ks[6], (DEPTH, SSD_HEADS), 0.01),
        "ssd_norm_w": 1.0 + nrm(ks[7], (DEPTH, D_INNER), 0.01),
        "fox_f_bias": 3.0 + nrm(ks[8], (DEPTH, FOX_HEADS), 0.5),
        "gate_bias": nrm(ks[9], (DEPTH, 2, D_MODEL), 0.01),
        "w_proj_ssd": nrm(ks[10], (DEPTH, D_INNER, D_MODEL), D_INNER ** -0.5),
        "w_proj_att": nrm(ks[11], (DEPTH, D_ATT, D_MODEL), D_ATT ** -0.5),
        "w_out": nrm(ks[12], (DEPTH, D_MODEL, D_MODEL), BETA * D_MODEL ** -0.5),
        "ln1_g": 1.0 + nrm(ks[13], (DEPTH, D_MODEL), 0.01),
        "ln1_b": nrm(ks[14], (DEPTH, D_MODEL), 0.01),
        "w_up": nrm(ks[15], (DEPTH, D_MODEL, 2 * D_FF), D_MODEL ** -0.5),
        "ffn_conv_w": nrm(ks[16], (DEPTH, FFN_CONV, 2 * D_FF), FFN_CONV ** -0.5),
        "ffn_conv_b": nrm(ks[17], (DEPTH, 2 * D_FF), 0.01),
        "w_down": nrm(ks[18], (DEPTH, D_FF, D_MODEL), BETA * D_FF ** -0.5),
        "ln2_g": 1.0 + nrm(ks[19], (DEPTH, D_MODEL), 0.01),
        "ln2_b": nrm(ks[20], (DEPTH, D_MODEL), 0.01),
    }


def reference(x, w_in, ssd_conv_w, ssd_conv_b, ssd_dt_bias, ssd_a_log, ssd_d, ssd_norm_w,
              fox_f_bias, gate_bias, w_proj_ssd, w_proj_att, w_out, ln1_g, ln1_b,
              w_up, ffn_conv_w, ffn_conv_b, w_down, ln2_g, ln2_b):
    h = x
    for layer in range(DEPTH):
        proj = jnp.einsum("bld,de->ble", h, w_in[layer])
        z, xbc, dt_raw, q, k, v, f_logit, g_ssd, g_att = jnp.split(proj, IN_SPLITS, axis=-1)
        y_ssd = _ssd_branch(z, xbc, dt_raw, ssd_conv_w[layer], ssd_conv_b[layer],
                            ssd_dt_bias[layer], ssd_a_log[layer], ssd_d[layer], ssd_norm_w[layer])
        y_att = _fox_branch(q, k, v, f_logit + fox_f_bias[layer])
        merged = (jax.nn.sigmoid(g_ssd + gate_bias[layer, 0]) * jnp.einsum("ble,ed->bld", y_ssd, w_proj_ssd[layer])
                  + jax.nn.sigmoid(g_att + gate_bias[layer, 1]) * jnp.einsum("ble,ed->bld", y_att, w_proj_att[layer]))
        mix = jnp.einsum("bld,de->ble", merged, w_out[layer])
        h = _layer_norm(ALPHA * h + mix, ln1_g[layer], ln1_b[layer])
        u = _causal_dwconv(jnp.einsum("bld,df->blf", h, w_up[layer]), ffn_conv_w[layer], ffn_conv_b[layer])
        val, gate = jnp.split(u, 2, axis=-1)
        f = jnp.einsum("blf,fd->bld", jax.nn.silu(gate) * val, w_down[layer])
        h = _layer_norm(ALPHA * h + f, ln2_g[layer], ln2_b[layer])
    return h
```

```cpp
#include <hip/hip_runtime.h>
#include <cstdio>
#include <cstdint>

#ifndef MK_ONE_LAUNCH
#define MK_ONE_LAUNCH 1
#endif

namespace cfg {
constexpr int D_MODEL = 4096, BATCH = 2, SEQ = 4096, T = BATCH * SEQ;
constexpr int D_INNER = 8192, SSD_P = 64, SSD_H = 128, SSD_N = 128, SSD_G = 8, SSD_R = 16, CONV_DIM = 10240;
constexpr int FOX_HD = 128, FOX_H = 32, D_ATT = 4096, D_FF = 11008;
constexpr int OFF_DT = 18432, OFF_Q = 18560, OFF_F = 30848, OFF_GS = 30880, NPROJ = 39072;
constexpr int PZ = 0, PXBC = 8192, PQ = 18432, PK = 22528, PV = 26624, PGS = 30720, PGA = 34816, LDP = 38912, PSMALL = 38912, NWIN = 39168;
constexpr int KM = 12288;
constexpr int NSLAB = 8, KSLAB = 512;
constexpr float ALPHA = 1.189207115002721f;
constexpr float LN_EPS = 1e-5f, RMS_EPS = 1e-5f;
constexpr size_t MiB = 1u << 20;
constexpr size_t WS_CTL = 0, CTL_ZERO_BYTES = 1 * MiB;
constexpr size_t WS_XB = 1 * MiB, WS_WIN = 65 * MiB, WS_WP = 371 * MiB, WS_WO = 467 * MiB, WS_WUP = 499 * MiB, WS_WD = 671 * MiB;
constexpr size_t WS_PROJ = 757 * MiB, WS_DTF = 1365 * MiB, WS_XACT = 1429 * MiB, WS_DTV = 1589 * MiB, WS_LC = 1593 * MiB, WS_CT = 1594 * MiB, WS_SSQ = 1595 * MiB;
constexpr size_t WS_AM = 1603 * MiB, WS_M1 = 1795 * MiB, WS_MG = 1923 * MiB, WS_H1 = 1987 * MiB, WS_H1B = 2115 * MiB, WS_END = 2179 * MiB;
constexpr size_t WS_U = WS_PROJ, WS_ACT = WS_PROJ + 344 * MiB;
static_assert(WS_WIN + (size_t)NWIN * D_MODEL * 2 == WS_WP && WS_WP + (size_t)D_MODEL * KM * 2 == WS_WO && WS_WUP + (size_t)2 * D_FF * D_MODEL * 2 == WS_WD && WS_WD + (size_t)D_MODEL * D_FF * 2 == WS_PROJ, "ws map (weights)");
static_assert(WS_PROJ + (size_t)T * LDP * 2 == WS_DTF && WS_DTF + (size_t)NSLAB * T * 256 * 4 == WS_XACT && WS_XACT + (size_t)T * CONV_DIM * 2 == WS_DTV && WS_AM + (size_t)T * KM * 2 == WS_M1, "ws map (activations)");
static_assert(WS_ACT + (size_t)T * D_FF * 2 <= WS_DTF && WS_U + (size_t)T * 2 * D_FF * 2 == WS_ACT, "u/act overlay proj");
constexpr int CW_BAR = 4096;
}
using namespace cfg;

#define LAS __attribute__((address_space(3)))
#define GAS __attribute__((address_space(1)))
typedef unsigned short bf16;
typedef short bf16x8 __attribute__((ext_vector_type(8)));
typedef float f32x4 __attribute__((ext_vector_type(4)));
typedef float f32x2 __attribute__((ext_vector_type(2)));
typedef unsigned u32x4 __attribute__((ext_vector_type(4)));
typedef unsigned u32x2 __attribute__((ext_vector_type(2)));
#define LDS_WAIT() asm volatile("s_waitcnt lgkmcnt(0)" ::: "memory")
#define VM_WAIT() asm volatile("s_waitcnt vmcnt(0)" ::: "memory")

__device__ __forceinline__ unsigned cvt_pk_bf16(float lo, float hi) { unsigned r; asm volatile("v_cvt_pk_bf16_f32 %0, %1, %2" : "=v"(r) : "v"(lo), "v"(hi)); return r; }
__device__ __forceinline__ float bf_lo(unsigned w) { return __uint_as_float(w << 16); }
__device__ __forceinline__ float bf_hi(unsigned w) { return __uint_as_float(w & 0xffff0000u); }
__device__ __forceinline__ float bf2f(bf16 b) { return __uint_as_float(((unsigned)b) << 16); }
__device__ __forceinline__ float silu_f(float x) { return x / (1.f + __expf(-x)); }
__device__ __forceinline__ float sigmoid_f(float x) { return 1.f / (1.f + __expf(-x)); }
__device__ __forceinline__ float softplus_f(float x) { return x > 20.f ? x : log1pf(__expf(x)); }
__device__ __forceinline__ float logsigmoid_f(float x) { return fminf(x, 0.f) - log1pf(__expf(-fabsf(x))); }

namespace pg8 {
constexpr int BM = 256, BK = 64, HALF = 128, HTB = HALF * BK * 2, STAGE_BYTES = 8 * HTB, NXCD = 8, WGM = 8;
__host__ __device__ __forceinline__ int lds_byte(int r, int c) { const int st = (r >> 4) * 2 + (c >> 5), rr = r & 15, cc = c & 31, ob = rr * 64 + cc * 2; return st * 1024 + (ob ^ (((ob >> 9) & 1) << 5)); }
__host__ __device__ __forceinline__ void stage_rc(int b, int& R, int& C) { const int st = b / 1024, sb = b % 1024, swz = sb ^ (((sb >> 9) & 1) << 5); R = (st >> 1) * 16 + swz / 64; C = (st & 1) * 32 + (swz % 64) / 2; }
__host__ __device__ __forceinline__ int perm32(int rho) { const int n = rho >> 4, i = rho & 15; return 8 * (i >> 2) + 4 * n + (i & 3); }

struct Unit { int pm, pn, ka; };
struct Gemm { const bf16* A; const bf16* Bt; int lda, ldb, K; };

struct StaticOrder {
    int nM, nN, nwg, G, c;
    __host__ __device__ void init(int M, int N, int G_, int c_) { nM = M / BM; nN = N / BM; nwg = nM * nN; G = G_; c = c_; }
    __host__ __device__ bool next(int i, Unit& u) const {
        const long L = (long)i * G + c; if (L >= nwg) return false;
        int wgid = (int)L; { const int q = nwg / NXCD, r = nwg % NXCD, xcd = wgid % NXCD, off = wgid / NXCD; wgid = (xcd < r ? xcd * (q + 1) : r * (q + 1) + (xcd - r) * q) + off; }
        const int nig = WGM * nN, gid = wgid / nig, fm = gid * WGM, gsz = (nM - fm) < WGM ? (nM - fm) : WGM;
        u.pm = fm + ((wgid % nig) % gsz); u.pn = (wgid % nig) / gsz; u.ka = 0; return true;
    }
    __device__ __forceinline__ void a_ready(const Unit&) const {}
    __device__ __forceinline__ void done(const Unit&) const {}
};
struct SplitKOrder {
    int nM, nS, kslab, G, c;
    __host__ __device__ bool next(int i, Unit& u) const { const long L = (long)i * G + c; if (L >= (long)nM * nS) return false; u.pm = (int)(L % nM); u.pn = 0; u.ka = (int)(L / nM) * kslab; return true; }
    __device__ __forceinline__ void a_ready(const Unit&) const {}
    __device__ __forceinline__ void done(const Unit&) const {}
};

struct EpiStoreBf16 {
    static constexpr bool PERM = true;
    bf16* O; int ldc;
    __device__ __forceinline__ void operator()(const f32x4 (&acc)[2][2][4][2], const Unit& u, int wr, int wc, int fr, int fq) const {
        const int row0 = u.pm * BM + wr * 64 + fr, col0 = u.pn * BM + wc * 32 + 8 * fq;
#pragma unroll
        for (int ai = 0; ai < 2; ++ai)
#pragma unroll
            for (int m = 0; m < 4; ++m) { bf16* rowp = O + (size_t)(row0 + ai * HALF + m * 16) * ldc + col0;
#pragma unroll
                for (int bj = 0; bj < 2; ++bj) { const f32x4 v0 = acc[ai][bj][m][0], v1 = acc[ai][bj][m][1];
                    u32x4 w; w.x = cvt_pk_bf16(v0[0], v0[1]); w.y = cvt_pk_bf16(v0[2], v0[3]); w.z = cvt_pk_bf16(v1[0], v1[1]); w.w = cvt_pk_bf16(v1[2], v1[3]);
                    *(u32x4*)(rowp + bj * HALF) = w; } }
    }
};
struct EpiSlabF32 {
    static constexpr bool PERM = false;
    float* C; int kslab; size_t slab_stride;
    __device__ __forceinline__ void operator()(const f32x4 (&acc)[2][2][4][2], const Unit& u, int wr, int wc, int fr, int fq) const {
        float* base = C + (size_t)(u.ka / kslab) * slab_stride;
        const int row0 = u.pm * BM + wr * 64 + fr, col0 = wc * 32 + 4 * fq;
#pragma unroll
        for (int ai = 0; ai < 2; ++ai)
#pragma unroll
            for (int m = 0; m < 4; ++m) { float* rowp = base + (size_t)(row0 + ai * HALF + m * 16) * 256 + col0;
#pragma unroll
                for (int bj = 0; bj < 2; ++bj)
#pragma unroll
                    for (int n = 0; n < 2; ++n) *(f32x4*)(rowp + bj * HALF + n * 16) = acc[ai][bj][m][n]; }
    }
};
struct EpiGate1 {
    static constexpr bool PERM = false;
    const bf16* proj; const float* gb; float* M1;
    __device__ __forceinline__ void operator()(const f32x4 (&acc)[2][2][4][2], const Unit& u, int wr, int wc, int fr, int fq) const {
        const int row0 = u.pm * BM + wr * 64 + fr, col0 = u.pn * BM + wc * 32 + 4 * fq;
        f32x4 bv[2][2];
#pragma unroll
        for (int bj = 0; bj < 2; ++bj)
#pragma unroll
            for (int n = 0; n < 2; ++n) bv[bj][n] = *(const f32x4*)(gb + col0 + bj * HALF + n * 16);
#pragma unroll
        for (int ai = 0; ai < 2; ++ai)
#pragma unroll
            for (int m = 0; m < 4; ++m) { const size_t r = (size_t)(row0 + ai * HALF + m * 16);
#pragma unroll
                for (int bj = 0; bj < 2; ++bj)
#pragma unroll
                    for (int n = 0; n < 2; ++n) { const int c = col0 + bj * HALF + n * 16; const u32x2 g = *(const u32x2*)(proj + r * LDP + PGS + c);
                        f32x4 o; o[0] = sigmoid_f(bf_lo(g.x) + bv[bj][n][0]) * acc[ai][bj][m][n][0]; o[1] = sigmoid_f(bf_hi(g.x) + bv[bj][n][1]) * acc[ai][bj][m][n][1];
                        o[2] = sigmoid_f(bf_lo(g.y) + bv[bj][n][2]) * acc[ai][bj][m][n][2]; o[3] = sigmoid_f(bf_hi(g.y) + bv[bj][n][3]) * acc[ai][bj][m][n][3];
                        *(f32x4*)(M1 + r * D_MODEL + c) = o; } }
    }
};
struct EpiGate2 {
    static constexpr bool PERM = true;
    const bf16* proj; const float* gb; const float* M1; bf16* MG;
    __device__ __forceinline__ void operator()(const f32x4 (&acc)[2][2][4][2], const Unit& u, int wr, int wc, int fr, int fq) const {
        const int row0 = u.pm * BM + wr * 64 + fr, col0 = u.pn * BM + wc * 32 + 8 * fq;
#pragma unroll
        for (int ai = 0; ai < 2; ++ai)
#pragma unroll
            for (int m = 0; m < 4; ++m) { const size_t r = (size_t)(row0 + ai * HALF + m * 16);
#pragma unroll
                for (int bj = 0; bj < 2; ++bj) { const int c = col0 + bj * HALF;
                    const u32x4 g = *(const u32x4*)(proj + r * LDP + PGA + c); const f32x4 b0 = *(const f32x4*)(gb + c), b1 = *(const f32x4*)(gb + c + 4);
                    const f32x4 p0 = *(const f32x4*)(M1 + r * D_MODEL + c), p1 = *(const f32x4*)(M1 + r * D_MODEL + c + 4);
                    const f32x4 v0 = acc[ai][bj][m][0], v1 = acc[ai][bj][m][1];
                    const float o0 = p0[0] + sigmoid_f(bf_lo(g.x) + b0[0]) * v0[0], o1 = p0[1] + sigmoid_f(bf_hi(g.x) + b0[1]) * v0[1];
                    const float o2 = p0[2] + sigmoid_f(bf_lo(g.y) + b0[2]) * v0[2], o3 = p0[3] + sigmoid_f(bf_hi(g.y) + b0[3]) * v0[3];
                    const float o4 = p1[0] + sigmoid_f(bf_lo(g.z) + b1[0]) * v1[0], o5 = p1[1] + sigmoid_f(bf_hi(g.z) + b1[1]) * v1[1];
                    const float o6 = p1[2] + sigmoid_f(bf_lo(g.w) + b1[2]) * v1[2], o7 = p1[3] + sigmoid_f(bf_hi(g.w) + b1[3]) * v1[3];
                    u32x4 w; w.x = cvt_pk_bf16(o0, o1); w.y = cvt_pk_bf16(o2, o3); w.z = cvt_pk_bf16(o4, o5); w.w = cvt_pk_bf16(o6, o7);
                    *(u32x4*)(MG + r * D_MODEL + c) = w; } }
    }
};
struct EpiResid {
    static constexpr bool PERM = false;
    const float* base; float* out;
    __device__ __forceinline__ void operator()(const f32x4 (&acc)[2][2][4][2], const Unit& u, int wr, int wc, int fr, int fq) const {
        const int row0 = u.pm * BM + wr * 64 + fr, col0 = u.pn * BM + wc * 32 + 4 * fq;
#pragma unroll
        for (int ai = 0; ai < 2; ++ai)
#pragma unroll
            for (int m = 0; m < 4; ++m) { const size_t off = (size_t)(row0 + ai * HALF + m * 16) * D_MODEL + col0;
#pragma unroll
                for (int bj = 0; bj < 2; ++bj)
#pragma unroll
                    for (int n = 0; n < 2; ++n) { const f32x4 bs = *(const f32x4*)(base + off + bj * HALF + n * 16); *(f32x4*)(out + off + bj * HALF + n * 16) = bs * ALPHA + acc[ai][bj][m][n]; } }
    }
};

template <class Epi, class Sched, bool ALIGN_EPI>
__device__ __forceinline__ void gemm_phase(LAS unsigned char* lds, const Gemm g, const Sched& S, const Epi& E) {
    const int tid = threadIdx.x, wid = __builtin_amdgcn_readfirstlane(tid >> 6), lane = tid & 63, wr = wid >> 2, wc = wid & 3, fr = lane & 15, fq = lane >> 4;
    const int nt = g.K / BK;
    unsigned voffA[2], voffB[2];
#pragma unroll
    for (int i = 0; i < 2; ++i) { int R, C; stage_rc(tid * 16 + i * 8192, R, C); const int Rb = Epi::PERM ? ((R & ~31) + perm32(R & 31)) : R;
        voffA[i] = (unsigned)(R * g.lda + C) * 2u; voffB[i] = (unsigned)(Rb * g.ldb + C) * 2u; }
    const size_t kstep = (size_t)(BK * 2);
    const size_t hA = (size_t)HALF * g.lda * 2, hB = (size_t)HALF * g.ldb * 2;
    const unsigned ldsw = (unsigned)wid * 1024u;
    const int aoff = lds_byte(wr * 64 + fr, fq * 8), boff = lds_byte(wc * 32 + fr, fq * 8);
#define PG8_SA(b, h) (((b) * 2 + (h)) * HTB)
#define PG8_SB(b, h) ((4 + (b) * 2 + (h)) * HTB)
#define PG8_STAGE(bufoff, gbase, voff) do { _Pragma("unroll") for (int _i = 0; _i < 2; ++_i) \
        __builtin_amdgcn_global_load_lds((const unsigned*)((const char*)(gbase) + (voff)[_i]), (LAS unsigned*)(lds + (bufoff) + ldsw + _i * 8192), 16, 0, 0); } while (0)
#define PG8_LDA(dst, b, h) do { _Pragma("unroll") for (int m = 0; m < 4; ++m) _Pragma("unroll") for (int k = 0; k < 2; ++k) dst[m][k] = *(const LAS bf16x8*)(lds + PG8_SA(b, h) + aoff + m * 2048 + k * 1024); } while (0)
#define PG8_LDB(dst, b, h) do { _Pragma("unroll") for (int n = 0; n < 2; ++n) _Pragma("unroll") for (int k = 0; k < 2; ++k) dst[n][k] = *(const LAS bf16x8*)(lds + PG8_SB(b, h) + boff + n * 2048 + k * 1024); } while (0)
#define PG8_MMA(ai, bj, At, Bt) do { __builtin_amdgcn_s_setprio(1); _Pragma("unroll") for (int m = 0; m < 4; ++m) _Pragma("unroll") for (int n = 0; n < 2; ++n) _Pragma("unroll") for (int k = 0; k < 2; ++k) \
        acc[ai][bj][m][n] = __builtin_amdgcn_mfma_f32_16x16x32_bf16(Bt[n][k], At[m][k], acc[ai][bj][m][n], 0, 0, 0); __builtin_amdgcn_s_setprio(0); } while (0)
#define PG8_WAIT_V(n) asm volatile("s_waitcnt vmcnt(" #n ")" ::: "memory")
#define PG8_WAIT_L(n) asm volatile("s_waitcnt lgkmcnt(" #n ")" ::: "memory")
#define PG8_BAR __builtin_amdgcn_s_barrier()
#define PG8_SCHED __builtin_amdgcn_sched_barrier(0)
    Unit cur, nxt; int ui = 0;
    if (!S.next(0, cur)) return;
    f32x4 acc[2][2][4][2];
#pragma unroll
    for (int a = 0; a < 2; ++a)
#pragma unroll
        for (int b = 0; b < 2; ++b)
#pragma unroll
            for (int m = 0; m < 4; ++m)
#pragma unroll
                for (int n = 0; n < 2; ++n) acc[a][b][m][n] = (f32x4){0.f, 0.f, 0.f, 0.f};
    bf16x8 At[4][2], B0[2][2], B1[2][2];
    const char* cA = (const char*)g.A + (size_t)cur.pm * 2 * hA + (size_t)cur.ka * 2; const char* cB = (const char*)g.Bt + (size_t)cur.pn * 2 * hB + (size_t)cur.ka * 2;
    S.a_ready(cur);
    PG8_STAGE(PG8_SB(0, 0), cB, voffB); PG8_STAGE(PG8_SB(0, 1), cB + hB, voffB); PG8_STAGE(PG8_SA(0, 0), cA, voffA); PG8_STAGE(PG8_SA(0, 1), cA + hA, voffA);
    if (wr == 1) PG8_BAR;
    PG8_WAIT_V(2); PG8_BAR;
    PG8_STAGE(PG8_SB(1, 0), cB + kstep, voffB); PG8_STAGE(PG8_SA(1, 0), cA + kstep, voffA); PG8_STAGE(PG8_SB(1, 1), cB + hB + kstep, voffB);
    PG8_WAIT_V(6); PG8_BAR;
    for (;;) {
        const bool has_next = S.next(ui + 1, nxt);
        const char* nA = has_next ? (const char*)g.A + (size_t)nxt.pm * 2 * hA + (size_t)nxt.ka * 2 : cA; const char* nB = has_next ? (const char*)g.Bt + (size_t)nxt.pn * 2 * hB + (size_t)nxt.ka * 2 : cB;
        for (int t = 0; t < nt; t += 2) {
            const bool last = (t == nt - 2);
            const char* a1 = cA + (size_t)(t + 1) * kstep;
            const char* a2 = last ? nA : cA + (size_t)(t + 2) * kstep; const char* b2 = last ? nB : cB + (size_t)(t + 2) * kstep;
            const char* a3 = a2 + kstep; const char* b3 = b2 + kstep;
            if (last && has_next) S.a_ready(nxt);
            PG8_LDB(B0, 0, 0); PG8_LDB(B1, 0, 1); PG8_SCHED; PG8_LDA(At, 0, 0); PG8_STAGE(PG8_SA(1, 1), a1 + hA, voffA);
            PG8_WAIT_V(8); PG8_WAIT_L(0); PG8_BAR; PG8_MMA(0, 0, At, B0); PG8_MMA(0, 1, At, B1); PG8_BAR; PG8_SCHED;
            PG8_LDA(At, 0, 1); PG8_STAGE(PG8_SB(0, 0), b2, voffB); PG8_STAGE(PG8_SB(0, 1), b2 + hB, voffB); PG8_STAGE(PG8_SA(0, 0), a2, voffA);
            PG8_WAIT_V(8); PG8_WAIT_L(0); PG8_BAR; PG8_MMA(1, 0, At, B0); PG8_MMA(1, 1, At, B1); PG8_BAR; PG8_SCHED;
            PG8_LDB(B0, 1, 0); PG8_LDB(B1, 1, 1); PG8_SCHED; PG8_LDA(At, 1, 0); PG8_STAGE(PG8_SA(0, 1), a2 + hA, voffA);
            PG8_WAIT_V(8); PG8_WAIT_L(0); PG8_BAR; PG8_MMA(0, 0, At, B0); PG8_MMA(0, 1, At, B1); PG8_BAR; PG8_SCHED;
            PG8_LDA(At, 1, 1); PG8_STAGE(PG8_SB(1, 0), b3, voffB); PG8_STAGE(PG8_SB(1, 1), b3 + hB, voffB); PG8_STAGE(PG8_SA(1, 0), a3, voffA);
            PG8_WAIT_V(8); PG8_WAIT_L(0); PG8_BAR; PG8_MMA(1, 0, At, B0); PG8_MMA(1, 1, At, B1); PG8_BAR; PG8_SCHED;
        }
        if constexpr (ALIGN_EPI) { if (wr == 0) PG8_BAR; }
        E(acc, cur, wr, wc, fr, fq); S.done(cur);
        if (!has_next) break;
#pragma unroll
        for (int a = 0; a < 2; ++a)
#pragma unroll
            for (int b = 0; b < 2; ++b)
#pragma unroll
                for (int m = 0; m < 4; ++m)
#pragma unroll
                    for (int n = 0; n < 2; ++n) acc[a][b][m][n] = (f32x4){0.f, 0.f, 0.f, 0.f};
        cur = nxt; cA = nA; cB = nB; ++ui;
        if constexpr (ALIGN_EPI) { if (wr == 1) PG8_BAR; }
    }
    PG8_WAIT_V(0);
    if constexpr (!ALIGN_EPI) { if (wr == 0) PG8_BAR; }
    PG8_BAR;
#undef PG8_SA
#undef PG8_SB
#undef PG8_STAGE
#undef PG8_LDA
#undef PG8_LDB
#undef PG8_MMA
#undef PG8_WAIT_V
#undef PG8_WAIT_L
#undef PG8_BAR
#undef PG8_SCHED
}
}

#define XB_TMO      128
#define XB_XCNT(j)  (256  + 64 * (j))
#define XB_XSUB(j)  (1280 + 64 * (j))
#define XB_XGEN(j)  (2304 + 64 * (j))
#define XB_TOP      3328
#define XB_TOPGEN   3392
#define XCD_BAR_WORDS 3456
#define XB_SPIN_CAP (1u << 20)
__device__ __forceinline__ unsigned xb_ld(unsigned* p)              { return __hip_atomic_load(p, __ATOMIC_RELAXED, __HIP_MEMORY_SCOPE_AGENT); }
__device__ __forceinline__ unsigned xb_add(unsigned* p, unsigned v) { return __hip_atomic_fetch_add(p, v, __ATOMIC_RELAXED, __HIP_MEMORY_SCOPE_AGENT); }
__device__ __forceinline__ unsigned xb_xcc_id() { return (unsigned)__builtin_amdgcn_s_getreg((3 << 11) | 20) & 0xFu; }
#define XB_SPIN(cond, bar) do { unsigned _sp = 0; while (cond) { __builtin_amdgcn_s_sleep(1); \
    if ((++_sp & 255u) == 0u) { if (xb_ld(&(bar)[XB_TMO])) break; if (_sp > XB_SPIN_CAP) { atomicAdd(&(bar)[XB_TMO], 1u); break; } } } } while (0)
struct XcdBarrier { unsigned* bar; unsigned x; volatile LAS unsigned* st; };
__device__ __forceinline__ XcdBarrier xcd_barrier_post(unsigned* bar, volatile LAS unsigned* st) {
    XcdBarrier b; b.bar = bar; b.x = xb_xcc_id(); b.st = st;
    if (threadIdx.x == 0) (void)xb_add(&bar[XB_XCNT(b.x)], 1u);
    return b;
}
__device__ __forceinline__ void xcd_barrier_complete(unsigned* bar, unsigned x, unsigned& nloc, unsigned& nx) {
    const unsigned G = gridDim.x * gridDim.y * gridDim.z;
    unsigned sum, cnt, mine, sp = 0u;
    for (;;) {
        sum = 0u; cnt = 0u; mine = 0u;
#pragma unroll
        for (unsigned j = 0; j < 16; ++j) { const unsigned c = xb_ld(&bar[XB_XCNT(j)]); sum += c; cnt += (c > 0u) ? 1u : 0u; mine = (j == x) ? c : mine; }
        if (sum == G) break;
        __builtin_amdgcn_s_sleep(1);
        if ((++sp & 255u) == 0u) { if (xb_ld(&bar[XB_TMO])) break; if (sp > XB_SPIN_CAP) { atomicAdd(&bar[XB_TMO], 1u); break; } }
    }
    nloc = mine > 0u ? mine : 1u; nx = cnt > 0u ? cnt : 1u;
}
__device__ __forceinline__ void xcd_barrier(const XcdBarrier& b) {
    asm volatile("s_waitcnt vmcnt(0)" ::: "memory");
    __syncthreads();
    if (threadIdx.x == 0) {
        unsigned* bar = b.bar;
        __builtin_amdgcn_s_waitcnt(0);
        unsigned nloc = b.st[0], nx = b.st[1];
        if (nloc == 0u) { xcd_barrier_complete(bar, b.x, nloc, nx); b.st[0] = nloc; b.st[1] = nx; }
        const unsigned old = xb_add(&bar[XB_XSUB(b.x)], 1u);
        const unsigned gen = old / nloc;
        if (old + 1u == (gen + 1u) * nloc) {
            __builtin_amdgcn_fence(__ATOMIC_RELEASE, "agent");
            asm volatile("s_waitcnt vmcnt(0)" ::: "memory");
            const unsigned og = xb_add(&bar[XB_TOP], 1u);
            const unsigned tg = og / nx;
            if (og + 1u == (tg + 1u) * nx) xb_add(&bar[XB_TOPGEN], 1u);
            else XB_SPIN(xb_ld(&bar[XB_TOPGEN]) == tg, bar);
            __builtin_amdgcn_fence(__ATOMIC_ACQUIRE, "agent");
            xb_add(&bar[XB_XGEN(b.x)], 1u);
            asm volatile("s_waitcnt vmcnt(0)" ::: "memory");
        } else {
            XB_SPIN(xb_ld(&bar[XB_XGEN(b.x)]) == gen, bar);
            __builtin_amdgcn_fence(__ATOMIC_ACQUIRE, "agent");
            asm volatile("s_waitcnt vmcnt(0)" ::: "memory");
        }
    }
    __syncthreads();
}

constexpr int NWAVES = 8;
constexpr int RING_BYTES = 131072, MISC_OFF = RING_BYTES + 320, LDS_BYTES = 147456;
struct Params {
    const float* in[21]; float* out; unsigned char* ws; int ph_lo, ph_hi;
};
struct Frame {
    LAS unsigned char* lds; int tid, lane, wave, G, gw, ngw;
    const float *x, *w_in, *conv_w, *conv_b, *dt_bias, *a_log, *ssd_d, *norm_w, *f_bias, *gate_bias, *w_pssd, *w_patt, *w_out, *ln1_g, *ln1_b, *w_up, *fconv_w, *fconv_b, *w_down, *ln2_g, *ln2_b;
    float* out;
    bf16 *XB, *WIN, *WP, *WO, *WUP, *WD, *PROJ, *XACT, *AM, *MG, *H1B, *U, *ACT;
    float *DTF, *DTV, *LC, *CT, *SSQ, *M1, *H1;
};

__device__ __forceinline__ void transpose_item(const float* __restrict__ W, int N, int k0, int n0, bf16* dst, int ldt, const float* kscale, LAS float* scr, int lane) {
    float v[32];
#pragma unroll
    for (int i = 0; i < 32; ++i) { const int kk = 2 * i + (lane >> 5); v[i] = __builtin_nontemporal_load(W + (size_t)(k0 + kk) * N + n0 + (lane & 31)); }
    if (kscale) {
#pragma unroll
        for (int i = 0; i < 32; ++i) { const int kk = 2 * i + (lane >> 5); v[i] *= kscale[k0 + kk]; } }
#pragma unroll
    for (int i = 0; i < 32; ++i) { const int kk = 2 * i + (lane >> 5); scr[kk * 33 + (lane & 31)] = v[i]; }
    LDS_WAIT();
    const int c = lane & 7;
#pragma unroll
    for (int j = 0; j < 4; ++j) { const int n = (lane >> 3) + 8 * j; const LAS float* s = scr + (8 * c) * 33 + n;
        u32x4 o; o.x = cvt_pk_bf16(s[0 * 33], s[1 * 33]); o.y = cvt_pk_bf16(s[2 * 33], s[3 * 33]); o.z = cvt_pk_bf16(s[4 * 33], s[5 * 33]); o.w = cvt_pk_bf16(s[6 * 33], s[7 * 33]);
        *(u32x4*)(dst + (size_t)n * ldt + 8 * c) = o; }
    LDS_WAIT();
}
__device__ __forceinline__ int win_row(int n) {
    return n < OFF_DT ? n : (n < OFF_Q ? PSMALL + (n - OFF_DT) : (n < OFF_F ? n - 128 : (n < OFF_GS ? PSMALL + 128 + (n - OFF_F) : n - 160)));
}
__device__ __forceinline__ void p0_prologue(Frame& F) {
    LAS float* scr = (LAS float*)(F.lds + F.wave * 16384);
    constexpr int I_IN = (D_MODEL / 64) * (NPROJ / 32), I_PS = (D_INNER / 64) * (D_MODEL / 32), I_PA = (D_ATT / 64) * (D_MODEL / 32), I_O = (D_MODEL / 64) * (D_MODEL / 32);
    constexpr int I_UP = (D_MODEL / 64) * (2 * D_FF / 32), I_DN = (D_FF / 64) * (D_MODEL / 32);
    constexpr int NITEMS = I_IN + I_PS + I_PA + I_O + I_UP + I_DN;
    for (int it = F.gw; it < NITEMS; it += F.ngw) {
        int r = it;
        if (r < I_IN) { const int nb = NPROJ / 32, kb = r / nb, n0 = (r % nb) * 32; transpose_item(F.w_in, NPROJ, kb * 64, n0, F.WIN + (size_t)win_row(n0) * D_MODEL + kb * 64, D_MODEL, nullptr, scr, F.lane); continue; } r -= I_IN;
        if (r < I_PS) { const int nb = D_MODEL / 32, kb = r / nb, n0 = (r % nb) * 32; transpose_item(F.w_pssd, D_MODEL, kb * 64, n0, F.WP + (size_t)n0 * KM + kb * 64, KM, F.norm_w, scr, F.lane); continue; } r -= I_PS;
        if (r < I_PA) { const int nb = D_MODEL / 32, kb = r / nb, n0 = (r % nb) * 32; transpose_item(F.w_patt, D_MODEL, kb * 64, n0, F.WP + (size_t)n0 * KM + D_INNER + kb * 64, KM, nullptr, scr, F.lane); continue; } r -= I_PA;
        if (r < I_O) { const int nb = D_MODEL / 32, kb = r / nb, n0 = (r % nb) * 32; transpose_item(F.w_out, D_MODEL, kb * 64, n0, F.WO + (size_t)n0 * D_MODEL + kb * 64, D_MODEL, nullptr, scr, F.lane); continue; } r -= I_O;
        if (r < I_UP) { const int nb = 2 * D_FF / 32, kb = r / nb, n0 = (r % nb) * 32; transpose_item(F.w_up, 2 * D_FF, kb * 64, n0, F.WUP + (size_t)n0 * D_MODEL + kb * 64, D_MODEL, nullptr, scr, F.lane); continue; } r -= I_UP;
        { const int nb = D_MODEL / 32, kb = r / nb, n0 = (r % nb) * 32; transpose_item(F.w_down, D_MODEL, kb * 64, n0, F.WD + (size_t)n0 * D_FF + kb * 64, D_FF, nullptr, scr, F.lane); }
    }
    const size_t gt = (size_t)F.gw * 64 + F.lane, nth = (size_t)F.ngw * 64;
    for (size_t i = gt; i < (size_t)T * D_MODEL / 8; i += nth) { const f32x4 a = *(const f32x4*)(F.x + i * 8), b = *(const f32x4*)(F.x + i * 8 + 4);
        u32x4 w; w.x = cvt_pk_bf16(a[0], a[1]); w.y = cvt_pk_bf16(a[2], a[3]); w.z = cvt_pk_bf16(b[0], b[1]); w.w = cvt_pk_bf16(b[2], b[3]); *(u32x4*)(F.XB + i * 8) = w; }
}

__device__ __forceinline__ void unpack8(const u32x4 w, float (&v)[8]) { v[0] = bf_lo(w.x); v[1] = bf_hi(w.x); v[2] = bf_lo(w.y); v[3] = bf_hi(w.y); v[4] = bf_lo(w.z); v[5] = bf_hi(w.z); v[6] = bf_lo(w.w); v[7] = bf_hi(w.w); }
__device__ __forceinline__ void p2_conv_item(Frame& F, int item) {
    const int tb = item / 20, cb = item % 20, t0 = tb * 16, c0 = cb * 512 + F.lane * 8;
    float w[4][8], bs[8];
#pragma unroll
    for (int k = 0; k < 4; ++k) { const f32x4 a = *(const f32x4*)(F.conv_w + k * CONV_DIM + c0), b = *(const f32x4*)(F.conv_w + k * CONV_DIM + c0 + 4);
#pragma unroll
        for (int j = 0; j < 4; ++j) { w[k][j] = a[j]; w[k][4 + j] = b[j]; } }
    { const f32x4 a = *(const f32x4*)(F.conv_b + c0), b = *(const f32x4*)(F.conv_b + c0 + 4);
#pragma unroll
      for (int j = 0; j < 4; ++j) { bs[j] = a[j]; bs[4 + j] = b[j]; } }
    float x0[8], x1[8], x2[8], x3[8];
    const bool first = (t0 & (SEQ - 1)) == 0;
    const bf16* src = F.PROJ + (size_t)t0 * LDP + PXBC + c0;
    if (first) {
#pragma unroll
        for (int j = 0; j < 8; ++j) { x0[j] = 0.f; x1[j] = 0.f; x2[j] = 0.f; } }
    else { unpack8(*(const u32x4*)(src - 3 * (size_t)LDP), x0); unpack8(*(const u32x4*)(src - 2 * (size_t)LDP), x1); unpack8(*(const u32x4*)(src - (size_t)LDP), x2); }
#pragma unroll 4
    for (int i = 0; i < 16; ++i) {
        unpack8(*(const u32x4*)(src + (size_t)i * LDP), x3);
        float o[8];
#pragma unroll
        for (int j = 0; j < 8; ++j) { float a = bs[j]; a = fmaf(w[0][j], x0[j], a); a = fmaf(w[1][j], x1[j], a); a = fmaf(w[2][j], x2[j], a); a = fmaf(w[3][j], x3[j], a); o[j] = silu_f(a); x0[j] = x1[j]; x1[j] = x2[j]; x2[j] = x3[j]; }
        u32x4 q; q.x = cvt_pk_bf16(o[0], o[1]); q.y = cvt_pk_bf16(o[2], o[3]); q.z = cvt_pk_bf16(o[4], o[5]); q.w = cvt_pk_bf16(o[6], o[7]);
        *(u32x4*)(F.XACT + (size_t)(t0 + i) * CONV_DIM + c0) = q;
    }
}
__device__ __forceinline__ void p2_dt_item(Frame& F, int item) {
#pragma unroll
    for (int j = 0; j < 8; ++j) { const int e = item * 512 + j * 64 + F.lane, t = e >> 7, h = e & 127; float s = 0.f;
#pragma unroll
        for (int ks = 0; ks < NSLAB; ++ks) s += F.DTF[((size_t)ks * T + t) * 256 + h];
        F.DTV[(size_t)t * SSD_H + h] = softplus_f(s + F.dt_bias[h]); }
}
__device__ __forceinline__ void p2_fcum_item(Frame& F, int item) {
    const int b = item >> 6, c = item & 63, t = b * SEQ + c * 64 + F.lane;
#pragma unroll 1
    for (int h4 = 0; h4 < FOX_H; h4 += 4) {
        f32x4 s = (f32x4){0.f, 0.f, 0.f, 0.f};
#pragma unroll
        for (int ks = 0; ks < NSLAB; ++ks) s += *(const f32x4*)(F.DTF + ((size_t)ks * T + t) * 256 + 128 + h4);
#pragma unroll
        for (int j = 0; j < 4; ++j) { float v = logsigmoid_f(s[j] + F.f_bias[h4 + j]);
#pragma unroll
            for (int o = 1; o < 64; o <<= 1) { const float u = __shfl_up(v, o); if (F.lane >= o) v += u; }
            F.LC[(size_t)(b * FOX_H + h4 + j) * SEQ + c * 64 + F.lane] = v;
            if (F.lane == 63) F.CT[(b * FOX_H + h4 + j) * 64 + c] = v; }
    }
}
__device__ __forceinline__ void p2_prep(Frame& F) {
    constexpr int N_FC = BATCH * 64, N_CONV = (T / 16) * 20, N_DT = T * SSD_H / 512;
    for (int it = F.gw; it < N_FC + N_CONV + N_DT; it += F.ngw) {
        if (it < N_FC) p2_fcum_item(F, it); else if (it < N_FC + N_CONV) p2_conv_item(F, it - N_FC); else p2_dt_item(F, it - N_FC - N_CONV);
    }
}

__device__ __forceinline__ void p5_norm(Frame& F) {
    for (int t = F.gw; t < T; t += F.ngw) {
        const f32x4 q = *(const f32x4*)(F.SSQ + (size_t)t * 256 + F.lane * 4);
        float s0 = (q[0] + q[1]) + (q[2] + q[3]);
#pragma unroll
        for (int o = 1; o < 8; o <<= 1) s0 += __shfl_xor(s0, o);
        const float r0 = rsqrtf(s0 * (1.f / 1024.f) + RMS_EPS);
        bf16* row = F.AM + (size_t)t * KM + F.lane * 8;
#pragma unroll
        for (int j = 0; j < 16; ++j) { const int g = j >> 1; const float r = __shfl(r0, g * 8);
            u32x4 w = *(const u32x4*)(row + j * 512); float v[8]; unpack8(w, v);
            w.x = cvt_pk_bf16(v[0] * r, v[1] * r); w.y = cvt_pk_bf16(v[2] * r, v[3] * r); w.z = cvt_pk_bf16(v[4] * r, v[5] * r); w.w = cvt_pk_bf16(v[6] * r, v[7] * r);
            *(u32x4*)(row + j * 512) = w; }
    }
}

__device__ __forceinline__ float wave_sum(float v) {
#pragma unroll
    for (int o = 1; o < 64; o <<= 1) v += __shfl_xor(v, o);
    return v;
}
template <bool WITH_BF16> __device__ __forceinline__ void ln_rows(Frame& F, const float* src, const float* g, const float* b, float* dst, bf16* dstb) {
    for (int t = F.gw; t < T; t += F.ngw) {
        const f32x4* xr = (const f32x4*)(src + (size_t)t * D_MODEL) + F.lane;
        f32x4 v[16]; float s = 0.f;
#pragma unroll
        for (int j = 0; j < 16; ++j) { v[j] = xr[64 * j]; s += (v[j][0] + v[j][1]) + (v[j][2] + v[j][3]); }
        const float mean = wave_sum(s) * (1.f / D_MODEL); float q = 0.f;
#pragma unroll
        for (int j = 0; j < 16; ++j) { v[j] = v[j] - mean; q += (v[j][0] * v[j][0] + v[j][1] * v[j][1]) + (v[j][2] * v[j][2] + v[j][3] * v[j][3]); }
        const float rstd = rsqrtf(wave_sum(q) * (1.f / D_MODEL) + LN_EPS);
#pragma unroll
        for (int j = 0; j < 16; ++j) { const int c = (64 * j + F.lane) * 4; const f32x4 gg = *(const f32x4*)(g + c), bb = *(const f32x4*)(b + c); const f32x4 o = v[j] * rstd * gg + bb;
            *(f32x4*)(dst + (size_t)t * D_MODEL + c) = o;
            if (WITH_BF16) { u32x2 w; w.x = cvt_pk_bf16(o[0], o[1]); w.y = cvt_pk_bf16(o[2], o[3]); *(u32x2*)(dstb + (size_t)t * D_MODEL + c) = w; } }
    }
}

__device__ __forceinline__ void p11_act_item(Frame& F, int item) {
    const int tb = item / 43, cb = item % 43, t0 = tb * 16, c0 = cb * 256 + F.lane * 4;
    f32x4 wv[3], wg[3];
#pragma unroll
    for (int k = 0; k < 3; ++k) { wv[k] = *(const f32x4*)(F.fconv_w + k * 2 * D_FF + c0); wg[k] = *(const f32x4*)(F.fconv_w + k * 2 * D_FF + D_FF + c0); }
    const f32x4 bv = *(const f32x4*)(F.fconv_b + c0), bg = *(const f32x4*)(F.fconv_b + D_FF + c0);
    const bool first = (t0 & (SEQ - 1)) == 0;
    const bf16* src = F.U + (size_t)t0 * (2 * D_FF) + c0;
    f32x4 v0, v1, g0, g1;
    auto ld4 = [](const bf16* p) { const u32x2 w = *(const u32x2*)p; return (f32x4){bf_lo(w.x), bf_hi(w.x), bf_lo(w.y), bf_hi(w.y)}; };
    if (first) { v0 = v1 = g0 = g1 = (f32x4){0.f, 0.f, 0.f, 0.f}; }
    else { v0 = ld4(src - 2 * (size_t)(2 * D_FF)); v1 = ld4(src - (size_t)(2 * D_FF)); g0 = ld4(src - 2 * (size_t)(2 * D_FF) + D_FF); g1 = ld4(src - (size_t)(2 * D_FF) + D_FF); }
#pragma unroll 4
    for (int i = 0; i < 16; ++i) {
        const f32x4 v2 = ld4(src + (size_t)i * (2 * D_FF)), g2 = ld4(src + (size_t)i * (2 * D_FF) + D_FF);
        const f32x4 cv = bv + wv[0] * v0 + wv[1] * v1 + wv[2] * v2, cg = bg + wg[0] * g0 + wg[1] * g1 + wg[2] * g2;
        u32x2 w; w.x = cvt_pk_bf16(silu_f(cg[0]) * cv[0], silu_f(cg[1]) * cv[1]); w.y = cvt_pk_bf16(silu_f(cg[2]) * cv[2], silu_f(cg[3]) * cv[3]);
        *(u32x2*)(F.ACT + (size_t)(t0 + i) * D_FF + c0) = w;
        v0 = v1; v1 = v2; g0 = g1; g1 = g2;
    }
}

namespace ssd {
typedef float f32x16 __attribute__((ext_vector_type(16)));
typedef LAS char* lptr;
constexpr int PCM = 272, PBM = 272, PBT = 144, PXT = 144, PHB = 272;
constexpr int O_CM = 0, O_BM = O_CM + 64 * PCM, O_BT = O_BM + 64 * PBM, O_XT = O_BT + 128 * PBT, O_HB = O_XT + 64 * PXT, O_VEC = O_HB + 64 * PHB, SSD_LDS = O_VEC + 1024;
constexpr int V_DT = 0, V_ACS = 256, V_W = 512, V_E = 768;
__device__ __forceinline__ int crow(int r, int hi) { return (r & 3) + 8 * (r >> 2) + 4 * hi; }
__device__ __forceinline__ void tr_block_write(const u32x4 (&blk)[8], lptr base, int pitch, int cg, int tg) {
#pragma unroll
    for (int j = 0; j < 8; ++j) {
        u32x4 o;
#pragma unroll
        for (int m = 0; m < 4; ++m) { const unsigned a = blk[2 * m][j >> 1], b = blk[2 * m + 1][j >> 1];
            o[m] = (j & 1) ? ((a >> 16) | (b & 0xffff0000u)) : ((a & 0xffffu) | (b << 16)); }
        *(LAS u32x4*)(base + (cg * 8 + j) * pitch + tg * 16) = o;
    }
}
struct Pre { u32x4 nat[4]; u32x4 blk[8]; float dtr; };
__device__ __forceinline__ void loads(Pre& P, const bf16* XACT, const float* DTV, size_t t0, int h, int g, int tid, int wid, int lane) {
    const int rowA = tid >> 4, ch = tid & 15;
    const bf16* cm = XACT + (t0 + rowA) * CONV_DIM + D_INNER + SSD_G * SSD_N + g * SSD_N + ch * 8;
    const bf16* bm = XACT + (t0 + rowA) * CONV_DIM + D_INNER + g * SSD_N + ch * 8;
    P.nat[0] = *(const u32x4*)cm; P.nat[1] = *(const u32x4*)(cm + 32 * (size_t)CONV_DIM); P.nat[2] = *(const u32x4*)bm; P.nat[3] = *(const u32x4*)(bm + 32 * (size_t)CONV_DIM);
    if (wid == 4) { const int cg = lane >> 3, tg = lane & 7; const bf16* p = XACT + (t0 + tg * 8) * CONV_DIM + h * SSD_P + cg * 8;
#pragma unroll
        for (int i = 0; i < 8; ++i) P.blk[i] = *(const u32x4*)(p + (size_t)i * CONV_DIM); }
    else if (wid == 5 || wid == 6) { const int idx = (wid - 5) * 64 + lane, cg = idx >> 3, tg = idx & 7; const bf16* p = XACT + (t0 + tg * 8) * CONV_DIM + D_INNER + g * SSD_N + cg * 8;
#pragma unroll
        for (int i = 0; i < 8; ++i) P.blk[i] = *(const u32x4*)(p + (size_t)i * CONV_DIM); }
    else if (wid == 7) P.dtr = DTV[(t0 + lane) * SSD_H + h];
}
__device__ __forceinline__ bf16x8 pack8f(const float (&v)[8]) { u32x4 w = {cvt_pk_bf16(v[0], v[1]), cvt_pk_bf16(v[2], v[3]), cvt_pk_bf16(v[4], v[5]), cvt_pk_bf16(v[6], v[7])}; return *reinterpret_cast<bf16x8*>(&w); }
__device__ __forceinline__ void phase(lptr lds, const bf16* PROJ, const bf16* XACT, const float* DTV, const float* a_log, const float* dskip, bf16* AM, float* SSQ, int G, int bx) {
    const int tid = threadIdx.x, wid = __builtin_amdgcn_readfirstlane(tid >> 6), lane = tid & 63, r32 = lane & 31, hi = lane >> 5;
    const LAS float* vec = (const LAS float*)(lds + O_VEC);
    for (int bh = bx; bh < BATCH * SSD_H; bh += G) {
        const int b = bh / SSD_H, h = bh % SSD_H, g = h / SSD_R;
        const float a = -__expf(a_log[h]), dsk = dskip[h];
        const size_t row0 = (size_t)b * SEQ;
        f32x16 st = {};
        Pre P;
        loads(P, XACT, DTV, row0, h, g, tid, wid, lane);
        for (int c = 0; c < SEQ / 64; ++c) {
            const size_t t0 = row0 + (size_t)c * 64;
            { const int rowA = tid >> 4, ch = tid & 15;
              *(LAS u32x4*)(lds + O_CM + rowA * PCM + ch * 16) = P.nat[0]; *(LAS u32x4*)(lds + O_CM + (rowA + 32) * PCM + ch * 16) = P.nat[1];
              *(LAS u32x4*)(lds + O_BM + rowA * PBM + ch * 16) = P.nat[2]; *(LAS u32x4*)(lds + O_BM + (rowA + 32) * PBM + ch * 16) = P.nat[3]; }
            if (wid == 4) tr_block_write(P.blk, lds + O_XT, PXT, lane >> 3, lane & 7);
            else if (wid == 5 || wid == 6) { const int idx = (wid - 5) * 64 + lane; tr_block_write(P.blk, lds + O_BT, PBT, idx >> 3, idx & 7); }
            else if (wid == 7) { const float dtv = P.dtr; float acs = dtv * a;
#pragma unroll
                for (int o = 1; o < 64; o <<= 1) { const float u = __shfl_up(acs, o); if (lane >= o) acs += u; }
                const float a63 = __shfl(acs, 63);
                LAS float* vw = (LAS float*)(lds + O_VEC);
                vw[V_DT / 4 + lane] = dtv; vw[V_ACS / 4 + lane] = acs; vw[V_W / 4 + lane] = __expf(a63 - acs) * dtv; vw[V_E / 4 + lane] = __expf(acs); }
            { const int nt = wid & 3, pt = wid >> 2; lptr hb = lds + O_HB + (32 * pt + r32) * PHB + (32 * nt + 4 * hi) * 2;
#pragma unroll
              for (int q = 0; q < 4; ++q) { u32x2 w; w.x = cvt_pk_bf16(st[4 * q], st[4 * q + 1]); w.y = cvt_pk_bf16(st[4 * q + 2], st[4 * q + 3]); *(LAS u32x2*)(hb + 16 * q) = w; } }
            LDS_WAIT(); __syncthreads();
            if (c + 1 < SEQ / 64) loads(P, XACT, DTV, t0 + 64, h, g, tid, wid, lane);
            if (wid < 4) {
                const int lt = wid & 1, pt2 = wid >> 1;
                const bf16* zp = PROJ + (t0 + 32 * lt + r32) * LDP + PZ + h * SSD_P + 32 * pt2 + 4 * hi;
                u32x2 zr[4];
#pragma unroll
                for (int q = 0; q < 4; ++q) zr[q] = *(const u32x2*)(zp + 8 * q);
                const float acsl = vec[V_ACS / 4 + 32 * lt + r32];
                bf16x8 gf[2][2];
                const lptr cmrow = lds + O_CM + (32 * lt + r32) * PCM + hi * 16;
#pragma unroll
                for (int s_ = 0; s_ < 2; ++s_) if (s_ <= lt) {
                    f32x16 cb = {};
                    const lptr bmrow = lds + O_BM + (32 * s_ + r32) * PBM + hi * 16;
#pragma unroll
                    for (int kk = 0; kk < 8; ++kk) cb = __builtin_amdgcn_mfma_f32_32x32x16_bf16(*(const LAS bf16x8*)(bmrow + kk * 32), *(const LAS bf16x8*)(cmrow + kk * 32), cb, 0, 0, 0);
                    float gv[16];
#pragma unroll
                    for (int q = 0; q < 4; ++q) { const f32x4 as4 = *(const LAS f32x4*)(vec + V_ACS / 4 + 32 * s_ + 8 * q + 4 * hi), dt4 = *(const LAS f32x4*)(vec + V_DT / 4 + 32 * s_ + 8 * q + 4 * hi);
#pragma unroll
                        for (int e = 0; e < 4; ++e) { const int srow = 32 * s_ + 8 * q + 4 * hi + e; gv[4 * q + e] = (srow <= 32 * lt + r32) ? cb[4 * q + e] * __expf(acsl - as4[e]) * dt4[e] : 0.f; } }
                    { float t8[8];
#pragma unroll
                      for (int e = 0; e < 8; ++e) t8[e] = gv[e];
                      gf[s_][0] = pack8f(t8);
#pragma unroll
                      for (int e = 0; e < 8; ++e) t8[e] = gv[8 + e];
                      gf[s_][1] = pack8f(t8); }
                }
                f32x16 y = {};
                { const lptr hbrow = lds + O_HB + (32 * pt2 + r32) * PHB + hi * 16;
#pragma unroll
                  for (int kk = 0; kk < 8; ++kk) y = __builtin_amdgcn_mfma_f32_32x32x16_bf16(*(const LAS bf16x8*)(hbrow + kk * 32), *(const LAS bf16x8*)(cmrow + kk * 32), y, 0, 0, 0); }
                { const float el = vec[V_E / 4 + 32 * lt + r32];
#pragma unroll
                  for (int r = 0; r < 16; ++r) y[r] *= el; }
                const lptr xtrow = lds + O_XT + (32 * pt2 + r32) * PXT + hi * 8;
#pragma unroll
                for (int s_ = 0; s_ < 2; ++s_) if (s_ <= lt) {
#pragma unroll
                    for (int s2 = 0; s2 < 2; ++s2) { const u32x2 lo = *(const LAS u32x2*)(xtrow + (32 * s_ + 16 * s2) * 2), hi2 = *(const LAS u32x2*)(xtrow + (32 * s_ + 16 * s2 + 8) * 2);
                        u32x4 aw = {lo.x, lo.y, hi2.x, hi2.y};
                        y = __builtin_amdgcn_mfma_f32_32x32x16_bf16(*reinterpret_cast<bf16x8*>(&aw), gf[s_][s2], y, 0, 0, 0); }
                }
                float ss = 0.f;
                bf16* op = AM + (t0 + 32 * lt + r32) * KM + h * SSD_P + 32 * pt2 + 4 * hi;
#pragma unroll
                for (int q = 0; q < 4; ++q) { float o4[4];
#pragma unroll
                    for (int e = 0; e < 4; ++e) { const int p = 32 * pt2 + 8 * q + 4 * hi + e; const float xs = bf2f(*(const LAS bf16*)(lds + O_XT + p * PXT + (32 * lt + r32) * 2));
                        const float zv = (e & 1) ? bf_hi(e < 2 ? zr[q].x : zr[q].y) : bf_lo(e < 2 ? zr[q].x : zr[q].y);
                        const float ov = (y[4 * q + e] + dsk * xs) * silu_f(zv); o4[e] = ov; ss += ov * ov; }
                    u32x2 w; w.x = cvt_pk_bf16(o4[0], o4[1]); w.y = cvt_pk_bf16(o4[2], o4[3]); *(u32x2*)(op + 8 * q) = w; }
                ss += __shfl_xor(ss, 32);
                if (hi == 0) SSQ[(t0 + 32 * lt + r32) * 256 + h * 2 + pt2] = ss;
            }
            { const int nt = wid & 3, pt = wid >> 2; const float cdec = vec[V_E / 4 + 63];
#pragma unroll
              for (int r = 0; r < 16; ++r) st[r] *= cdec;
              const lptr btrow = lds + O_BT + (32 * nt + r32) * PBT + hi * 16; const lptr xtrow = lds + O_XT + (32 * pt + r32) * PXT + hi * 16;
#pragma unroll
              for (int ks = 0; ks < 4; ++ks) { const u32x4 xr = *(const LAS u32x4*)(xtrow + ks * 32);
                  const f32x4 w0 = *(const LAS f32x4*)(vec + V_W / 4 + 16 * ks + 8 * hi), w1 = *(const LAS f32x4*)(vec + V_W / 4 + 16 * ks + 8 * hi + 4);
                  float xv[8]; unpack8(xr, xv);
#pragma unroll
                  for (int e = 0; e < 4; ++e) { xv[e] *= w0[e]; xv[4 + e] *= w1[e]; }
                  st = __builtin_amdgcn_mfma_f32_32x32x16_bf16(*(const LAS bf16x8*)(btrow + ks * 32), pack8f(xv), st, 0, 0, 0); } }
            LDS_WAIT(); __syncthreads();
        }
    }
}
}

namespace fox {
constexpr float SCALE = 0.08838834764831845f;
constexpr int NW = 8, QBLK = 32, KVBLK = 64, QB = NW * QBLK, D = 128;
constexpr int SHM_V = KVBLK * D * 2, SHM_K = KVBLK * D * 2;
constexpr int OFF_WS = 2 * SHM_V + 2 * SHM_K, OFF_BL = OFF_WS + NW * 64 * 4, OFF_PREF = OFF_BL + SEQ * 4, ATTN_LDS = OFF_PREF + 256;
constexpr float THR = 8.f;
typedef short s16x4 __attribute__((ext_vector_type(4)));
typedef float f32x16 __attribute__((ext_vector_type(16)));
typedef LAS char* lptr;
#define KSWZ(row, colB) ((row) * 256 + ((colB) ^ (((row) & 7) << 4)))
#define SBAR() __builtin_amdgcn_sched_barrier(0)
__device__ __forceinline__ int v_st(int k, int c) { const int kk = (k & ~0xC) | ((k & 4) << 1) | ((k & 8) >> 1); return ((kk >> 3) * 4 + (c >> 5)) * 512 + ((kk & 7) * 32 + (c & 31)) * 2; }
__device__ __forceinline__ int v_rd_base(int lane) { return ((lane & 3) << 3) | (((lane >> 2) & 3) << 6) | (((lane >> 4) & 1) << 5) | (((lane >> 5) & 1) << 8); }
constexpr int v_rd_off(int d0, int ks, int half) { return d0 * 512 + ks * 4096 + half * 2048; }
__device__ __forceinline__ int crow(int r, int hi) { return (r & 3) + 8 * (r >> 2) + 4 * hi; }
__device__ __forceinline__ bf16x8 ld8(const bf16* p) { return *reinterpret_cast<const bf16x8*>(p); }
__device__ __forceinline__ void mask_tile(f32x16& p0, f32x16& p1, int dq) {
    const float NEG = -__builtin_inff();
#pragma unroll
    for (int r = 0; r < 16; ++r) { const int c = (r & 3) + 8 * (r >> 2); if (dq - c < 0) p0[r] = NEG; if (dq - c - 32 < 0) p1[r] = NEG; }
}
__device__ __forceinline__ void partialSM(f32x16& p0, f32x16& p1, float& m_reg, float& mn, float& alpha) {
    float pmax = p0[0];
#pragma unroll
    for (int r = 1; r < 16; ++r) pmax = fmaxf(pmax, p0[r]);
#pragma unroll
    for (int r = 0; r < 16; ++r) pmax = fmaxf(pmax, p1[r]);
    { auto rr = __builtin_amdgcn_permlane32_swap(__float_as_uint(pmax), __float_as_uint(pmax), false, false); pmax = fmaxf(__uint_as_float(rr[0]), __uint_as_float(rr[1])); }
    constexpr float C2 = 1.4426950408889634f * SCALE;
    if (__builtin_expect(__all((pmax - m_reg) * SCALE <= THR), 1)) { mn = m_reg; alpha = 1.f; }
    else { mn = fmaxf(m_reg, pmax); alpha = __builtin_amdgcn_exp2f((m_reg - mn) * C2); m_reg = mn; }
    const float mnL = -mn * C2;
#pragma unroll
    for (int r = 0; r < 16; ++r) p0[r] = fmaf(p0[r], C2, mnL);
#pragma unroll
    for (int r = 0; r < 16; ++r) p1[r] = fmaf(p1[r], C2, mnL);
#pragma unroll
    for (int r = 0; r < 16; ++r) p0[r] = __builtin_amdgcn_exp2f(p0[r]);
}
__device__ __forceinline__ void finishSM(f32x16& p0, f32x16& p1, float alpha, float& l_reg, bf16x8& pa0, bf16x8& pa1, bf16x8& pa2, bf16x8& pa3) {
#pragma unroll
    for (int r = 0; r < 16; ++r) p1[r] = __builtin_amdgcn_exp2f(p1[r]);
    float ps = 0;
#pragma unroll
    for (int r = 0; r < 16; ++r) ps += p0[r];
#pragma unroll
    for (int r = 0; r < 16; ++r) ps += p1[r];
    { auto rr = __builtin_amdgcn_permlane32_swap(__float_as_uint(ps), __float_as_uint(ps), false, false); ps = __uint_as_float(rr[0]) + __uint_as_float(rr[1]); }
    l_reg = l_reg * alpha + ps;
#define PK4(P, B_, OUT) do { unsigned a0 = cvt_pk_bf16(P[B_+0], P[B_+1]), a1 = cvt_pk_bf16(P[B_+2], P[B_+3]);                          \
        unsigned b0 = cvt_pk_bf16(P[B_+4], P[B_+5]), b1 = cvt_pk_bf16(P[B_+6], P[B_+7]);                                             \
        auto r0 = __builtin_amdgcn_permlane32_swap(a0, b0, false, false); auto r1 = __builtin_amdgcn_permlane32_swap(a1, b1, false, false); \
        u32x4 w = {r0[0], r1[0], r0[1], r1[1]}; OUT = *reinterpret_cast<bf16x8*>(&w); } while (0)
    PK4(p0, 0, pa0); PK4(p0, 8, pa1); PK4(p1, 0, pa2); PK4(p1, 8, pa3);
#undef PK4
}
template <int KB>
__device__ __forceinline__ void qkt(f32x16& p0, f32x16& p1, lptr K_lds, int r32, int hi, const bf16x8* qr, const LAS float* blk) {
    { const LAS f32x4* bp = (const LAS f32x4*)blk;
      const f32x4 a0 = bp[0], a1 = bp[2], a2 = bp[4], a3 = bp[6], c0 = bp[8], c1 = bp[10], c2 = bp[12], c3 = bp[14];
      p0 = (f32x16){a0[0], a0[1], a0[2], a0[3], a1[0], a1[1], a1[2], a1[3], a2[0], a2[1], a2[2], a2[3], a3[0], a3[1], a3[2], a3[3]};
      p1 = (f32x16){c0[0], c0[1], c0[2], c0[3], c1[0], c1[1], c1[2], c1[3], c2[0], c2[1], c2[2], c2[3], c3[0], c3[1], c3[2], c3[3]}; }
    lptr kb[4];
#pragma unroll
    for (int dd = 0; dd < 4; ++dd) kb[dd] = K_lds + KB * SHM_K + KSWZ(r32, (dd * 16 + hi * 8) * 2);
#pragma unroll
    for (int d0 = 0; d0 < 8; ++d0) { lptr a = kb[d0 & 3] + (d0 >> 2) * 128;
        bf16x8 b0 = *(const LAS bf16x8*)(a);
        bf16x8 b1 = *(const LAS bf16x8*)(a + 32 * 256);
        p0 = __builtin_amdgcn_mfma_f32_32x32x16_bf16(b0, qr[d0], p0, 0, 0, 0);
        p1 = __builtin_amdgcn_mfma_f32_32x32x16_bf16(b1, qr[d0], p1, 0, 0, 0); }
}
template <int VB>
__device__ __forceinline__ void pv_tile(f32x16* o, int vb0, bf16x8 pa0, bf16x8 pa1, bf16x8 pa2, bf16x8 pa3) {
#define TRRD(dst, off) asm volatile("ds_read_b64_tr_b16 %0, %1 offset:%2" : "=&v"(dst) : "v"(vb0), "i"(off) : "memory")
#define PV_D0(d0) do { s16x4 l0, l1, l2, l3, h0, h1, h2, h3; constexpr int b_ = VB * SHM_V + v_rd_off(d0, 0, 0); \
        TRRD(l0, b_); TRRD(h0, b_ + 2048); TRRD(l1, b_ + 4096); TRRD(h1, b_ + 6144); TRRD(l2, b_ + 8192); TRRD(h2, b_ + 10240); TRRD(l3, b_ + 12288); TRRD(h3, b_ + 14336); \
        asm volatile("s_waitcnt lgkmcnt(0)" ::: "memory"); SBAR();   \
        o[d0] = __builtin_amdgcn_mfma_f32_32x32x16_bf16(pa0, (bf16x8){l0[0], l0[1], l0[2], l0[3], h0[0], h0[1], h0[2], h0[3]}, o[d0], 0, 0, 0);   \
        o[d0] = __builtin_amdgcn_mfma_f32_32x32x16_bf16(pa1, (bf16x8){l1[0], l1[1], l1[2], l1[3], h1[0], h1[1], h1[2], h1[3]}, o[d0], 0, 0, 0);   \
        o[d0] = __builtin_amdgcn_mfma_f32_32x32x16_bf16(pa2, (bf16x8){l2[0], l2[1], l2[2], l2[3], h2[0], h2[1], h2[2], h2[3]}, o[d0], 0, 0, 0);   \
        o[d0] = __builtin_amdgcn_mfma_f32_32x32x16_bf16(pa3, (bf16x8){l3[0], l3[1], l3[2], l3[3], h3[0], h3[1], h3[2], h3[3]}, o[d0], 0, 0, 0); } while (0)
    PV_D0(0); PV_D0(1); PV_D0(2); PV_D0(3);
#undef PV_D0
#undef TRRD
}
struct BlockRef { const bf16* Q; const bf16* K; const bf16* V; bf16* O; int P0; };
struct Seam { bf16x8 qr[8]; bf16x8 st_v0, st_v1, st_k0, st_k1; };
#define ROWB(p, k0, half) ((const char*)((p) + (size_t)(k0) * LDP) + ((half) ? voff1 : voff0))
#define VMW() asm volatile("s_waitcnt vmcnt(0)" ::: "memory")
#define VMWN(n) asm volatile("s_waitcnt vmcnt(%0)" :: "i"(n) : "memory")
#define SLOAD_H(Kp, Vp, k0) do { S.st_v0 = ld8((const bf16*)ROWB(Vp, k0, 0)); S.st_v1 = ld8((const bf16*)ROWB(Vp, k0, 1)); S.st_k0 = ld8((const bf16*)ROWB(Kp, k0, 0)); S.st_k1 = ld8((const bf16*)ROWB(Kp, k0, 1)); } while (0)
#define SWRITE_HK(bf) do { *(LAS bf16x8*)(K_lds + (bf) * SHM_K + kws) = S.st_k0; *(LAS bf16x8*)(K_lds + (bf) * SHM_K + kws + 32 * 256) = S.st_k1; } while (0)
#define SWRITE_HV(bf) do { *(LAS bf16x8*)(V_lds + (bf) * SHM_V + vst0) = S.st_v0; *(LAS bf16x8*)(V_lds + (bf) * SHM_V + vst1) = S.st_v1; } while (0)
#define SWRITE_H(bf) do { SWRITE_HV(bf); SWRITE_HK(bf); } while (0)
__device__ __forceinline__ void prime(const BlockRef& cur, lptr lds, Seam& S) {
    const int tid = threadIdx.x, wid = __builtin_amdgcn_readfirstlane(tid >> 6), lane = tid & 63, r32 = lane & 31, hi = lane >> 5;
    const int sr = tid >> 4, sc = (tid & 15) * 8, kws = KSWZ(sr, sc * 2); lptr K_lds = lds + 2 * SHM_V;
    const unsigned voff0 = (unsigned)(sr * LDP + sc) * 2u, voff1 = voff0 + 32u * LDP * 2u;
#pragma unroll
    for (int d0 = 0; d0 < 8; ++d0) S.qr[d0] = ld8((const bf16*)((const char*)cur.Q + (unsigned)((wid * QBLK + r32) * LDP + hi * 8) * 2u + d0 * 32));
    SLOAD_H(cur.K, cur.V, 0); VMW(); SWRITE_HK(0);
    __syncthreads();
}
__device__ __forceinline__ void block(const BlockRef& cur, const BlockRef& nxt, lptr lds, Seam& S) {
    const int tid = threadIdx.x, wid = __builtin_amdgcn_readfirstlane(tid >> 6), lane = tid & 63, r32 = lane & 31, hi = lane >> 5;
    const int NT = (cur.P0 + QB) / KVBLK;
    const int qlo = cur.P0 + wid * QBLK, qm = qlo + r32 - 4 * hi;
    lptr V_lds = lds; lptr K_lds = lds + 2 * SHM_V;
    LAS float* ws = (LAS float*)(lds + OFF_WS) + wid * 64; LAS float* li_l = ws; LAS float* al_l = ws + 32;
    const LAS float* bl = (const LAS float*)(lds + OFF_BL) + 4 * hi;
    float m_reg = -1e30f, l_reg = 0; f32x16 o[4] = {};
    const int sr = tid >> 4, sc = (tid & 15) * 8, vst0 = v_st(sr, sc), vst1 = v_st(32 + sr, sc), kws = KSWZ(sr, sc * 2);
    const unsigned voff0 = (unsigned)(sr * LDP + sc) * 2u, voff1 = voff0 + 32u * LDP * 2u;
    const int vb0 = (int)(unsigned)(uintptr_t)V_lds + v_rd_base(lane);
    const bf16* Kh = cur.K; const bf16* Vh = cur.V;
#define RESC(a) do { if (__any((a) < 1.f)) { if (hi == 0) al_l[r32] = (a); asm volatile("s_waitcnt lgkmcnt(0)" ::: "memory");              \
                     for (int d_ = 0; d_ < 4; ++d_) for (int r = 0; r < 16; ++r) o[d_][r] *= al_l[crow(r, hi)]; } } while (0)
#define KBASE(t) ((t) * KVBLK)
#define MASKT(P0_, P1_, t) do { const int kb_ = KBASE(t); if (kb_ + KVBLK - 1 > qlo) mask_tile(P0_, P1_, qm - kb_); } while (0)
#define SEAM_K0() do { VMWN(8); SWRITE_HK(0); SBAR(); } while (0)
    f32x16 pA0, pA1, pB0, pB1; float mnA, mnB, alA, alB; bf16x8 pa0, pa1, pa2, pa3;
    SWRITE_HV(0); SBAR();
    if (NT > 1) SLOAD_H(Kh, Vh, KBASE(1));
    SBAR(); qkt<0>(pA0, pA1, K_lds, r32, hi, S.qr, bl + KBASE(0));
    MASKT(pA0, pA1, 0); partialSM(pA0, pA1, m_reg, mnA, alA);
    if (NT > 1) { VMW(); SWRITE_H(1); }
    __syncthreads();
#define HALF_STEP(PX0, PX1, mnX, alX, PY0, PY1, alY, t, KB, VB, SB) do {                                                      \
        SBAR(); qkt<KB>(PX0, PX1, K_lds, r32, hi, S.qr, bl + KBASE(t));                                                       \
        finishSM(PY0, PY1, alY, l_reg, pa0, pa1, pa2, pa3); SBAR();                                                           \
        if ((t) + 1 < NT) { SLOAD_H(Kh, Vh, KBASE((t) + 1)); SBAR(); }                                                        \
        pv_tile<VB>(o, vb0, pa0, pa1, pa2, pa3); MASKT(PX0, PX1, (t)); partialSM(PX0, PX1, m_reg, mnX, alX);                  \
        __syncthreads();                                                                                                      \
        if ((t) + 1 < NT) { VMW(); SWRITE_H(SB); }                                                                            \
        RESC(alX); __syncthreads(); } while (0)
    for (int t = 1; t + 1 < NT; t += 2) {
        HALF_STEP(pB0, pB1, mnB, alB, pA0, pA1, alA, t, 1, 0, 0);
        HALF_STEP(pA0, pA1, mnA, alA, pB0, pB1, alB, t + 1, 0, 1, 1);
    }
    SBAR(); qkt<1>(pB0, pB1, K_lds, r32, hi, S.qr, bl + KBASE(NT - 1)); SBAR();
    SLOAD_H(nxt.K, nxt.V, 0); SBAR();
#pragma unroll
    for (int d0 = 0; d0 < 8; ++d0) S.qr[d0] = ld8((const bf16*)((const char*)nxt.Q + (unsigned)((wid * QBLK + r32) * LDP + hi * 8) * 2u + d0 * 32));
    SBAR();
    finishSM(pA0, pA1, alA, l_reg, pa0, pa1, pa2, pa3); SBAR();
    pv_tile<0>(o, vb0, pa0, pa1, pa2, pa3);
    MASKT(pB0, pB1, NT - 1); partialSM(pB0, pB1, m_reg, mnB, alB); __syncthreads(); RESC(alB);
    finishSM(pB0, pB1, alB, l_reg, pa0, pa1, pa2, pa3); SBAR(); pv_tile<1>(o, vb0, pa0, pa1, pa2, pa3);
    SBAR(); SEAM_K0();
    if (hi == 0) li_l[r32] = l_reg; asm volatile("s_waitcnt lgkmcnt(0)" ::: "memory");
    float rli[16];
#pragma unroll
    for (int r = 0; r < 16; ++r) rli[r] = __builtin_amdgcn_rcpf(li_l[crow(r, hi)]);
    bf16* Ow = cur.O + (size_t)(wid * QBLK) * KM;
#pragma unroll
    for (int r = 0; r < 16; ++r) { const int orow = crow(r, hi);
#pragma unroll
        for (int d0 = 0; d0 < 4; ++d0) { const float v = o[d0][r] * rli[r];
            const float vn = __shfl_xor(v, 1);
            if ((r32 & 1) == 0) *(unsigned*)(Ow + (size_t)orow * KM + d0 * 32 + r32) = cvt_pk_bf16(v, vn); } }
    __syncthreads();
#undef RESC
#undef KBASE
#undef MASKT
#undef SEAM_K0
#undef HALF_STEP
}
#undef ROWB
#undef VMW
#undef VMWN
#undef SLOAD_H
#undef SWRITE_HK
#undef SWRITE_HV
#undef SWRITE_H
struct Item { int bh, qb0, qb1; };
__device__ __forceinline__ Item decode(int L) { Item it; it.bh = L >> 3; const int x = L & 7; it.qb0 = x; it.qb1 = 15 - x; return it; }
__device__ __forceinline__ BlockRef ref(const Item& it, int pass, const bf16* PROJ, bf16* AM) {
    const int qb = pass ? it.qb1 : it.qb0, b = it.bh / FOX_H, h = it.bh % FOX_H; BlockRef r;
    const size_t row0 = (size_t)b * SEQ;
    r.Q = PROJ + (row0 + (size_t)qb * QB) * LDP + PQ + h * D; r.K = PROJ + row0 * LDP + PK + h * D; r.V = PROJ + row0 * LDP + PV + h * D;
    r.O = AM + (row0 + (size_t)qb * QB) * KM + D_INNER + h * D; r.P0 = qb * QB; return r;
}
__device__ __forceinline__ void build_bias(lptr lds, const float* LCh, int P0) {
    const LAS float* pref = (const LAS float*)(lds + OFF_PREF); LAS float* bl = (LAS float*)(lds + OFF_BL);
    int s0 = threadIdx.x * 8; asm volatile("" : "+v"(s0));
    if (s0 < P0 + QB) {
        const float fref = LCh[P0] + pref[P0 >> 6]; const float pc = pref[s0 >> 6];
        const f32x4 a = *(const f32x4*)(LCh + s0), b = *(const f32x4*)(LCh + s0 + 4);
        constexpr float IS = 1.f / SCALE;
        *(LAS f32x4*)(bl + s0) = (fref - (a + pc)) * IS; *(LAS f32x4*)(bl + s0 + 4) = (fref - (b + pc)) * IS;
    }
}
__device__ __forceinline__ void build_pref(lptr lds, const float* CTh) {
    int lane = threadIdx.x; asm volatile("" : "+v"(lane));
    if (lane < 64) { const float v = CTh[lane]; float inc = v;
#pragma unroll
        for (int o = 1; o < 64; o <<= 1) { const float u = __shfl_up(inc, o); if (lane >= o) inc += u; }
        ((LAS float*)(lds + OFF_PREF))[lane] = inc - v; }
}
__device__ __forceinline__ void phase(lptr lds, const bf16* PROJ, const float* LC, const float* CT, bf16* AM, int G, int bx) {
    const int total = 8 * BATCH * FOX_H, stride = G;
    int L = (G % 8 == 0) ? (bx % 8) * (G / 8) + bx / 8 : bx;
    if (L >= total) return;
    Item it = decode(L); int pass = 0;
    BlockRef cur = ref(it, 0, PROJ, AM);
    Seam S;
    build_pref(lds, CT + it.bh * 64);
    prime(cur, lds, S);
    for (;;) {
        const bool more_pass = pass == 0, more_item = L + stride < total, last = !more_pass && !more_item;
        Item itn = it; int passn = pass + 1, Ln = L;
        if (!more_pass) { passn = 0; Ln = more_item ? L + stride : L; itn = decode(Ln); }
        const BlockRef nxt = last ? cur : ref(itn, passn, PROJ, AM);
        build_bias(lds, LC + (size_t)it.bh * SEQ, cur.P0);
        __syncthreads();
        block(cur, nxt, lds, S);
        if (last) break;
        if (itn.bh != it.bh) { build_pref(lds, CT + itn.bh * 64); __syncthreads(); }
        cur = nxt; it = itn; pass = passn; L = Ln;
    }
}
#undef KSWZ
#undef SBAR
}

enum { PH_PROLOGUE = 0, PH_INPROJ, PH_PREP, PH_SSD, PH_ATTN, PH_NORM, PH_MERGE1, PH_MERGE2, PH_MIX, PH_LN1, PH_UP, PH_ACT, PH_DOWN, PH_LN2, PH_COUNT };

__global__ void __launch_bounds__(NWAVES * 64, 2) mk_fwd(Params p) {
    extern __shared__ __attribute__((aligned(16))) unsigned char lds_raw[];
    Frame F;
    F.lds = (LAS unsigned char*)lds_raw;
    volatile LAS unsigned* MISC = (volatile LAS unsigned*)(F.lds + MISC_OFF);
    F.tid = threadIdx.x; F.lane = F.tid & 63; F.wave = __builtin_amdgcn_readfirstlane(F.tid >> 6);
    F.G = gridDim.x; F.gw = blockIdx.x * NWAVES + F.wave; F.ngw = F.G * NWAVES;
    F.x = p.in[0]; F.w_in = p.in[1]; F.conv_w = p.in[2]; F.conv_b = p.in[3]; F.dt_bias = p.in[4]; F.a_log = p.in[5]; F.ssd_d = p.in[6]; F.norm_w = p.in[7]; F.f_bias = p.in[8]; F.gate_bias = p.in[9];
    F.w_pssd = p.in[10]; F.w_patt = p.in[11]; F.w_out = p.in[12]; F.ln1_g = p.in[13]; F.ln1_b = p.in[14]; F.w_up = p.in[15]; F.fconv_w = p.in[16]; F.fconv_b = p.in[17]; F.w_down = p.in[18]; F.ln2_g = p.in[19]; F.ln2_b = p.in[20];
    F.out = p.out;
    unsigned char* ws = p.ws;
    F.XB = (bf16*)(ws + WS_XB); F.WIN = (bf16*)(ws + WS_WIN); F.WP = (bf16*)(ws + WS_WP); F.WO = (bf16*)(ws + WS_WO); F.WUP = (bf16*)(ws + WS_WUP); F.WD = (bf16*)(ws + WS_WD);
    F.PROJ = (bf16*)(ws + WS_PROJ); F.XACT = (bf16*)(ws + WS_XACT); F.AM = (bf16*)(ws + WS_AM); F.MG = (bf16*)(ws + WS_MG); F.H1B = (bf16*)(ws + WS_H1B); F.U = (bf16*)(ws + WS_U); F.ACT = (bf16*)(ws + WS_ACT);
    F.DTF = (float*)(ws + WS_DTF); F.DTV = (float*)(ws + WS_DTV); F.LC = (float*)(ws + WS_LC); F.CT = (float*)(ws + WS_CT); F.SSQ = (float*)(ws + WS_SSQ); F.M1 = (float*)(ws + WS_M1); F.H1 = (float*)(ws + WS_H1);
    for (int u = F.tid; u < (LDS_BYTES - RING_BYTES) / 4; u += NWAVES * 64) ((LAS unsigned*)(F.lds + RING_BYTES))[u] = 0u;
    __syncthreads();
    const int lo = p.ph_lo, hi = p.ph_hi;
    XcdBarrier bar; bar.bar = (unsigned*)(ws + WS_CTL) + CW_BAR; bar.x = 0; bar.st = nullptr;
    if (hi - lo > 1) bar = xcd_barrier_post((unsigned*)(ws + WS_CTL) + CW_BAR, MISC + 8);
#define IN(k) (lo <= (k) && (k) < hi)
#define SEAM(k) do { if (IN(k) && IN((k) + 1)) xcd_barrier(bar); } while (0)

    if (IN(PH_PROLOGUE)) { p0_prologue(F); } SEAM(PH_PROLOGUE);

    if (IN(PH_INPROJ)) {
        { pg8::Gemm g{F.XB, F.WIN, D_MODEL, D_MODEL, D_MODEL}; pg8::StaticOrder S; S.init(T, LDP, F.G, (int)blockIdx.x); pg8::EpiStoreBf16 E{F.PROJ, LDP};
          pg8::gemm_phase<pg8::EpiStoreBf16, pg8::StaticOrder, true>(F.lds, g, S, E); }
        { pg8::Gemm g{F.XB, F.WIN + (size_t)PSMALL * D_MODEL, D_MODEL, D_MODEL, KSLAB}; pg8::SplitKOrder S{T / 256, NSLAB, KSLAB, F.G, (int)blockIdx.x}; pg8::EpiSlabF32 E{F.DTF, KSLAB, (size_t)T * 256};
          pg8::gemm_phase<pg8::EpiSlabF32, pg8::SplitKOrder, false>(F.lds, g, S, E); }
    } SEAM(PH_INPROJ);

    if (IN(PH_PREP)) { p2_prep(F); } SEAM(PH_PREP);

    if (IN(PH_SSD)) { ssd::phase((ssd::lptr)F.lds, F.PROJ, F.XACT, F.DTV, F.a_log, F.ssd_d, F.AM, F.SSQ, F.G, (int)blockIdx.x); } SEAM(PH_SSD);
    if (IN(PH_ATTN)) { fox::phase((fox::lptr)F.lds, F.PROJ, F.LC, F.CT, F.AM, F.G, (int)blockIdx.x); } SEAM(PH_ATTN);

    if (IN(PH_NORM)) { p5_norm(F); } SEAM(PH_NORM);

    if (IN(PH_MERGE1)) { pg8::Gemm g{F.AM, F.WP, KM, KM, D_INNER}; pg8::StaticOrder S; S.init(T, D_MODEL, F.G, (int)blockIdx.x); pg8::EpiGate1 E{F.PROJ, F.gate_bias, F.M1};
        pg8::gemm_phase<pg8::EpiGate1, pg8::StaticOrder, true>(F.lds, g, S, E); } SEAM(PH_MERGE1);

    if (IN(PH_MERGE2)) { pg8::Gemm g{F.AM + D_INNER, F.WP + D_INNER, KM, KM, D_ATT}; pg8::StaticOrder S; S.init(T, D_MODEL, F.G, (int)blockIdx.x); pg8::EpiGate2 E{F.PROJ, F.gate_bias + D_MODEL, F.M1, F.MG};
        pg8::gemm_phase<pg8::EpiGate2, pg8::StaticOrder, true>(F.lds, g, S, E); } SEAM(PH_MERGE2);

    if (IN(PH_MIX)) { pg8::Gemm g{F.MG, F.WO, D_MODEL, D_MODEL, D_MODEL}; pg8::StaticOrder S; S.init(T, D_MODEL, F.G, (int)blockIdx.x); pg8::EpiResid E{F.x, F.M1};
        pg8::gemm_phase<pg8::EpiResid, pg8::StaticOrder, true>(F.lds, g, S, E); } SEAM(PH_MIX);

    if (IN(PH_LN1)) { ln_rows<true>(F, F.M1, F.ln1_g, F.ln1_b, F.H1, F.H1B); } SEAM(PH_LN1);

    if (IN(PH_UP)) { pg8::Gemm g{F.H1B, F.WUP, D_MODEL, D_MODEL, D_MODEL}; pg8::StaticOrder S; S.init(T, 2 * D_FF, F.G, (int)blockIdx.x); pg8::EpiStoreBf16 E{F.U, 2 * D_FF};
        pg8::gemm_phase<pg8::EpiStoreBf16, pg8::StaticOrder, true>(F.lds, g, S, E); } SEAM(PH_UP);

    if (IN(PH_ACT)) { constexpr int N_ACT = (T / 16) * 43; for (int it = F.gw; it < N_ACT; it += F.ngw) p11_act_item(F, it); } SEAM(PH_ACT);

    if (IN(PH_DOWN)) { pg8::Gemm g{F.ACT, F.WD, D_FF, D_FF, D_FF}; pg8::StaticOrder S; S.init(T, D_MODEL, F.G, (int)blockIdx.x); pg8::EpiResid E{F.H1, F.M1};
        pg8::gemm_phase<pg8::EpiResid, pg8::StaticOrder, true>(F.lds, g, S, E); } SEAM(PH_DOWN);

    if (IN(PH_LN2)) { ln_rows<false>(F, F.M1, F.ln2_g, F.ln2_b, F.out, nullptr); }
#undef IN
#undef SEAM
}

extern "C" void kernel_launch(void* const* d_in, const int* in_sizes, int n_in, void* d_out, int out_size, void* d_ws, size_t ws_size, hipStream_t stream) {
    static int grid = 0;
    if (grid == 0) {
        if (n_in != 21 || in_sizes[0] != T * D_MODEL || out_size != T * D_MODEL || ws_size < WS_END) { fprintf(stderr, "kernel_launch: unexpected shapes (n_in %d, in0 %d, out %d, ws %zu < %zu); nothing launched\n", n_in, n_in > 0 ? in_sizes[0] : -1, out_size, ws_size, (size_t)WS_END); grid = -1; return; }
        int dev = 0, cus = 0, per_cu = 0;
        if (hipGetDevice(&dev) != hipSuccess || hipDeviceGetAttribute(&cus, hipDeviceAttributeMultiprocessorCount, dev) != hipSuccess) { grid = -1; return; }
        if (hipFuncSetAttribute((const void*)mk_fwd, hipFuncAttributeMaxDynamicSharedMemorySize, LDS_BYTES) != hipSuccess) { fprintf(stderr, "kernel_launch: hipFuncSetAttribute failed\n"); grid = -1; return; }
        if (hipOccupancyMaxActiveBlocksPerMultiprocessor(&per_cu, (const void*)mk_fwd, NWAVES * 64, LDS_BYTES) != hipSuccess || per_cu < 1) fprintf(stderr, "kernel_launch: note: occupancy query reports %d workgroups per CU\n", per_cu);
        (void)hipGetLastError();
        grid = cus;
    }
    if (grid < 0) return;
    (void)hipMemsetAsync((char*)d_ws + WS_CTL, 0, CTL_ZERO_BYTES, stream);
    Params p{};
    for (int i = 0; i < 21; ++i) p.in[i] = (const float*)d_in[i];
    p.out = (float*)d_out; p.ws = (unsigned char*)d_ws;
#if MK_ONE_LAUNCH
    p.ph_lo = 0; p.ph_hi = PH_COUNT;
    hipLaunchKernelGGL(mk_fwd, dim3(grid), dim3(NWAVES * 64), LDS_BYTES, stream, p);
#else
    for (int ph = 0; ph < PH_COUNT; ++ph) {
        p.ph_lo = ph; p.ph_hi = ph + 1;
        hipLaunchKernelGGL(mk_fwd, dim3(grid), dim3(NWAVES * 64), LDS_BYTES, stream, p);
    }
#endif
}
```

```cpp
#include <hip/hip_runtime.h>
#include <cstdio>
#include <cstdint>

#ifndef PROBE_MASK
#define PROBE_MASK 0
#endif
#ifndef MK_ONE_LAUNCH
#define MK_ONE_LAUNCH 1
#endif

namespace cfg {
constexpr int D_MODEL = 4096, BATCH = 2, SEQ = 4096, T = BATCH * SEQ;
constexpr int D_INNER = 8192, SSD_P = 64, SSD_H = 128, SSD_N = 128, SSD_G = 8, SSD_R = 16, CONV_DIM = 10240;
constexpr int FOX_HD = 128, FOX_H = 32, D_ATT = 4096, D_FF = 11008;
constexpr int OFF_DT = 18432, OFF_Q = 18560, OFF_F = 30848, OFF_GS = 30880, NPROJ = 39072;
constexpr int PZ = 0, PXBC = 8192, PQ = 18432, PK = 22528, PV = 26624, PGS = 30720, PGA = 34816, LDP = 38912, PSMALL = 38912, NWIN = 39168;
constexpr int KM = 12288;
constexpr int NSLAB = 8, KSLAB = 512;
constexpr float ALPHA = 1.189207115002721f;
constexpr float LN_EPS = 1e-5f, RMS_EPS = 1e-5f;
constexpr size_t MiB = 1u << 20;
constexpr size_t WS_CTL = 0, CTL_ZERO_BYTES = 1 * MiB;
constexpr size_t WS_XB = 1 * MiB, WS_WIN = 65 * MiB, WS_WP = 371 * MiB, WS_WO = 467 * MiB, WS_WUP = 499 * MiB, WS_WD = 671 * MiB;
constexpr size_t WS_PROJ = 757 * MiB, WS_DTF = 1365 * MiB, WS_XACT = 1429 * MiB, WS_DTV = 1589 * MiB, WS_LC = 1593 * MiB, WS_CT = 1594 * MiB, WS_SSQ = 1595 * MiB;
constexpr size_t WS_AM = 1603 * MiB, WS_M1 = 1795 * MiB, WS_MG = 1923 * MiB, WS_H1 = 1987 * MiB, WS_H1B = 2115 * MiB, WS_END = 2179 * MiB;
constexpr size_t WS_U = WS_PROJ, WS_ACT = WS_PROJ + 344 * MiB;
static_assert(WS_WIN + (size_t)NWIN * D_MODEL * 2 == WS_WP && WS_WP + (size_t)D_MODEL * KM * 2 == WS_WO && WS_WUP + (size_t)2 * D_FF * D_MODEL * 2 == WS_WD && WS_WD + (size_t)D_MODEL * D_FF * 2 == WS_PROJ, "ws map (weights)");
static_assert(WS_PROJ + (size_t)T * LDP * 2 == WS_DTF && WS_DTF + (size_t)NSLAB * T * 256 * 4 == WS_XACT && WS_XACT + (size_t)T * CONV_DIM * 2 == WS_DTV && WS_AM + (size_t)T * KM * 2 == WS_M1, "ws map (activations)");
static_assert(WS_ACT + (size_t)T * D_FF * 2 <= WS_DTF && WS_U + (size_t)T * 2 * D_FF * 2 == WS_ACT, "u/act overlay proj");
constexpr int CW_BAR = 4096;
}
using namespace cfg;

#define LAS __attribute__((address_space(3)))
#define GAS __attribute__((address_space(1)))
typedef unsigned short bf16;
typedef short bf16x8 __attribute__((ext_vector_type(8)));
typedef float f32x4 __attribute__((ext_vector_type(4)));
typedef float f32x2 __attribute__((ext_vector_type(2)));
typedef unsigned u32x4 __attribute__((ext_vector_type(4)));
typedef unsigned u32x2 __attribute__((ext_vector_type(2)));
#define LDS_WAIT() asm volatile("s_waitcnt lgkmcnt(0)" ::: "memory")
#define VM_WAIT() asm volatile("s_waitcnt vmcnt(0)" ::: "memory")

__device__ __forceinline__ unsigned cvt_pk_bf16(float lo, float hi) { unsigned r; asm volatile("v_cvt_pk_bf16_f32 %0, %1, %2" : "=v"(r) : "v"(lo), "v"(hi)); return r; }
__device__ __forceinline__ float bf_lo(unsigned w) { return __uint_as_float(w << 16); }
__device__ __forceinline__ float bf_hi(unsigned w) { return __uint_as_float(w & 0xffff0000u); }
__device__ __forceinline__ float bf2f(bf16 b) { return __uint_as_float(((unsigned)b) << 16); }
__device__ __forceinline__ float silu_f(float x) { return x / (1.f + __expf(-x)); }
__device__ __forceinline__ float sigmoid_f(float x) { return 1.f / (1.f + __expf(-x)); }
__device__ __forceinline__ float softplus_f(float x) { return x > 20.f ? x : log1pf(__expf(x)); }
__device__ __forceinline__ float logsigmoid_f(float x) { return fminf(x, 0.f) - log1pf(__expf(-fabsf(x))); }

namespace pg8 {
constexpr int BM = 256, BK = 64, HALF = 128, HTB = HALF * BK * 2, STAGE_BYTES = 8 * HTB, NXCD = 8, WGM = 8;
__host__ __device__ __forceinline__ int lds_byte(int r, int c) { const int st = (r >> 4) * 2 + (c >> 5), rr = r & 15, cc = c & 31, ob = rr * 64 + cc * 2; return st * 1024 + (ob ^ (((ob >> 9) & 1) << 5)); }
__host__ __device__ __forceinline__ void stage_rc(int b, int& R, int& C) { const int st = b / 1024, sb = b % 1024, swz = sb ^ (((sb >> 9) & 1) << 5); R = (st >> 1) * 16 + swz / 64; C = (st & 1) * 32 + (swz % 64) / 2; }
__host__ __device__ __forceinline__ int perm32(int rho) { const int n = rho >> 4, i = rho & 15; return 8 * (i >> 2) + 4 * n + (i & 3); }

struct Unit { int pm, pn, ka; };
struct Gemm { const bf16* A; const bf16* Bt; int lda, ldb, K; };

struct StaticOrder {
    int nM, nN, nwg, G, c;
    __host__ __device__ void init(int M, int N, int G_, int c_) { nM = M / BM; nN = N / BM; nwg = nM * nN; G = G_; c = c_; }
    __host__ __device__ bool next(int i, Unit& u) const {
        const long L = (long)i * G + c; if (L >= nwg) return false;
        int wgid = (int)L; { const int q = nwg / NXCD, r = nwg % NXCD, xcd = wgid % NXCD, off = wgid / NXCD; wgid = (xcd < r ? xcd * (q + 1) : r * (q + 1) + (xcd - r) * q) + off; }
        const int nig = WGM * nN, gid = wgid / nig, fm = gid * WGM, gsz = (nM - fm) < WGM ? (nM - fm) : WGM;
        u.pm = fm + ((wgid % nig) % gsz); u.pn = (wgid % nig) / gsz; u.ka = 0; return true;
    }
    __device__ __forceinline__ void a_ready(const Unit&) const {}
    __device__ __forceinline__ void done(const Unit&) const {}
};
struct SplitKOrder {
    int nM, nS, kslab, G, c;
    __host__ __device__ bool next(int i, Unit& u) const { const long L = (long)i * G + c; if (L >= (long)nM * nS) return false; u.pm = (int)(L % nM); u.pn = 0; u.ka = (int)(L / nM) * kslab; return true; }
    __device__ __forceinline__ void a_ready(const Unit&) const {}
    __device__ __forceinline__ void done(const Unit&) const {}
};

struct EpiStoreBf16 {
    static constexpr bool PERM = true;
    bf16* O; int ldc;
    __device__ __forceinline__ void operator()(const f32x4 (&acc)[2][2][4][2], const Unit& u, int wr, int wc, int fr, int fq) const {
        const int row0 = u.pm * BM + wr * 64 + fr, col0 = u.pn * BM + wc * 32 + 8 * fq;
#pragma unroll
        for (int ai = 0; ai < 2; ++ai)
#pragma unroll
            for (int m = 0; m < 4; ++m) { bf16* rowp = O + (size_t)(row0 + ai * HALF + m * 16) * ldc + col0;
#pragma unroll
                for (int bj = 0; bj < 2; ++bj) { const f32x4 v0 = acc[ai][bj][m][0], v1 = acc[ai][bj][m][1];
                    u32x4 w; w.x = cvt_pk_bf16(v0[0], v0[1]); w.y = cvt_pk_bf16(v0[2], v0[3]); w.z = cvt_pk_bf16(v1[0], v1[1]); w.w = cvt_pk_bf16(v1[2], v1[3]);
                    *(u32x4*)(rowp + bj * HALF) = w; } }
    }
};
struct EpiSlabF32 {
    static constexpr bool PERM = false;
    float* C; int kslab; size_t slab_stride;
    __device__ __forceinline__ void operator()(const f32x4 (&acc)[2][2][4][2], const Unit& u, int wr, int wc, int fr, int fq) const {
        float* base = C + (size_t)(u.ka / kslab) * slab_stride;
        const int row0 = u.pm * BM + wr * 64 + fr, col0 = wc * 32 + 4 * fq;
#pragma unroll
        for (int ai = 0; ai < 2; ++ai)
#pragma unroll
            for (int m = 0; m < 4; ++m) { float* rowp = base + (size_t)(row0 + ai * HALF + m * 16) * 256 + col0;
#pragma unroll
                for (int bj = 0; bj < 2; ++bj)
#pragma unroll
                    for (int n = 0; n < 2; ++n) *(f32x4*)(rowp + bj * HALF + n * 16) = acc[ai][bj][m][n]; }
    }
};
struct EpiGate1 {
    static constexpr bool PERM = false;
    const bf16* proj; const float* gb; float* M1;
    __device__ __forceinline__ void operator()(const f32x4 (&acc)[2][2][4][2], const Unit& u, int wr, int wc, int fr, int fq) const {
        const int row0 = u.pm * BM + wr * 64 + fr, col0 = u.pn * BM + wc * 32 + 4 * fq;
        f32x4 bv[2][2];
#pragma unroll
        for (int bj = 0; bj < 2; ++bj)
#pragma unroll
            for (int n = 0; n < 2; ++n) bv[bj][n] = *(const f32x4*)(gb + col0 + bj * HALF + n * 16);
#pragma unroll
        for (int ai = 0; ai < 2; ++ai)
#pragma unroll
            for (int m = 0; m < 4; ++m) { const size_t r = (size_t)(row0 + ai * HALF + m * 16);
#pragma unroll
                for (int bj = 0; bj < 2; ++bj)
#pragma unroll
                    for (int n = 0; n < 2; ++n) { const int c = col0 + bj * HALF + n * 16; const u32x2 g = *(const u32x2*)(proj + r * LDP + PGS + c);
                        f32x4 o; o[0] = sigmoid_f(bf_lo(g.x) + bv[bj][n][0]) * acc[ai][bj][m][n][0]; o[1] = sigmoid_f(bf_hi(g.x) + bv[bj][n][1]) * acc[ai][bj][m][n][1];
                        o[2] = sigmoid_f(bf_lo(g.y) + bv[bj][n][2]) * acc[ai][bj][m][n][2]; o[3] = sigmoid_f(bf_hi(g.y) + bv[bj][n][3]) * acc[ai][bj][m][n][3];
                        *(f32x4*)(M1 + r * D_MODEL + c) = o; } }
    }
};
struct EpiGate2 {
    static constexpr bool PERM = true;
    const bf16* proj; const float* gb; const float* M1; bf16* MG;
    __device__ __forceinline__ void operator()(const f32x4 (&acc)[2][2][4][2], const Unit& u, int wr, int wc, int fr, int fq) const {
        const int row0 = u.pm * BM + wr * 64 + fr, col0 = u.pn * BM + wc * 32 + 8 * fq;
#pragma unroll
        for (int ai = 0; ai < 2; ++ai)
#pragma unroll
            for (int m = 0; m < 4; ++m) { const size_t r = (size_t)(row0 + ai * HALF + m * 16);
#pragma unroll
                for (int bj = 0; bj < 2; ++bj) { const int c = col0 + bj * HALF;
                    const u32x4 g = *(const u32x4*)(proj + r * LDP + PGA + c); const f32x4 b0 = *(const f32x4*)(gb + c), b1 = *(const f32x4*)(gb + c + 4);
                    const f32x4 p0 = *(const f32x4*)(M1 + r * D_MODEL + c), p1 = *(const f32x4*)(M1 + r * D_MODEL + c + 4);
                    const f32x4 v0 = acc[ai][bj][m][0], v1 = acc[ai][bj][m][1];
                    const float o0 = p0[0] + sigmoid_f(bf_lo(g.x) + b0[0]) * v0[0], o1 = p0[1] + sigmoid_f(bf_hi(g.x) + b0[1]) * v0[1];
                    const float o2 = p0[2] + sigmoid_f(bf_lo(g.y) + b0[2]) * v0[2], o3 = p0[3] + sigmoid_f(bf_hi(g.y) + b0[3]) * v0[3];
                    const float o4 = p1[0] + sigmoid_f(bf_lo(g.z) + b1[0]) * v1[0], o5 = p1[1] + sigmoid_f(bf_hi(g.z) + b1[1]) * v1[1];
                    const float o6 = p1[2] + sigmoid_f(bf_lo(g.w) + b1[2]) * v1[2], o7 = p1[3] + sigmoid_f(bf_hi(g.w) + b1[3]) * v1[3];
                    u32x4 w; w.x = cvt_pk_bf16(o0, o1); w.y = cvt_pk_bf16(o2, o3); w.z = cvt_pk_bf16(o4, o5); w.w = cvt_pk_bf16(o6, o7);
                    *(u32x4*)(MG + r * D_MODEL + c) = w; } }
    }
};
struct EpiResid {
    static constexpr bool PERM = false;
    const float* base; float* out;
    __device__ __forceinline__ void operator()(const f32x4 (&acc)[2][2][4][2], const Unit& u, int wr, int wc, int fr, int fq) const {
        const int row0 = u.pm * BM + wr * 64 + fr, col0 = u.pn * BM + wc * 32 + 4 * fq;
#pragma unroll
        for (int ai = 0; ai < 2; ++ai)
#pragma unroll
            for (int m = 0; m < 4; ++m) { const size_t off = (size_t)(row0 + ai * HALF + m * 16) * D_MODEL + col0;
#pragma unroll
                for (int bj = 0; bj < 2; ++bj)
#pragma unroll
                    for (int n = 0; n < 2; ++n) { const f32x4 bs = *(const f32x4*)(base + off + bj * HALF + n * 16); *(f32x4*)(out + off + bj * HALF + n * 16) = bs * ALPHA + acc[ai][bj][m][n]; } }
    }
};

template <class Epi, class Sched, bool ALIGN_EPI>
__device__ __forceinline__ void gemm_phase(LAS unsigned char* lds, const Gemm g, const Sched& S, const Epi& E) {
    const int tid = threadIdx.x, wid = __builtin_amdgcn_readfirstlane(tid >> 6), lane = tid & 63, wr = wid >> 2, wc = wid & 3, fr = lane & 15, fq = lane >> 4;
    const int nt = g.K / BK;
    unsigned voffA[2], voffB[2];
#pragma unroll
    for (int i = 0; i < 2; ++i) { int R, C; stage_rc(tid * 16 + i * 8192, R, C); const int Rb = Epi::PERM ? ((R & ~31) + perm32(R & 31)) : R;
        voffA[i] = (unsigned)(R * g.lda + C) * 2u; voffB[i] = (unsigned)(Rb * g.ldb + C) * 2u; }
    const size_t kstep = (size_t)(BK * 2);
    const size_t hA = (size_t)HALF * g.lda * 2, hB = (size_t)HALF * g.ldb * 2;
    const unsigned ldsw = (unsigned)wid * 1024u;
    const int aoff = lds_byte(wr * 64 + fr, fq * 8), boff = lds_byte(wc * 32 + fr, fq * 8);
#define PG8_SA(b, h) (((b) * 2 + (h)) * HTB)
#define PG8_SB(b, h) ((4 + (b) * 2 + (h)) * HTB)
#define PG8_STAGE(bufoff, gbase, voff) do { _Pragma("unroll") for (int _i = 0; _i < 2; ++_i) \
        __builtin_amdgcn_global_load_lds((const unsigned*)((const char*)(gbase) + (voff)[_i]), (LAS unsigned*)(lds + (bufoff) + ldsw + _i * 8192), 16, 0, 0); } while (0)
#define PG8_LDA(dst, b, h) do { _Pragma("unroll") for (int m = 0; m < 4; ++m) _Pragma("unroll") for (int k = 0; k < 2; ++k) dst[m][k] = *(const LAS bf16x8*)(lds + PG8_SA(b, h) + aoff + m * 2048 + k * 1024); } while (0)
#define PG8_LDB(dst, b, h) do { _Pragma("unroll") for (int n = 0; n < 2; ++n) _Pragma("unroll") for (int k = 0; k < 2; ++k) dst[n][k] = *(const LAS bf16x8*)(lds + PG8_SB(b, h) + boff + n * 2048 + k * 1024); } while (0)
#define PG8_MMA(ai, bj, At, Bt) do { __builtin_amdgcn_s_setprio(1); _Pragma("unroll") for (int m = 0; m < 4; ++m) _Pragma("unroll") for (int n = 0; n < 2; ++n) _Pragma("unroll") for (int k = 0; k < 2; ++k) \
        acc[ai][bj][m][n] = __builtin_amdgcn_mfma_f32_16x16x32_bf16(Bt[n][k], At[m][k], acc[ai][bj][m][n], 0, 0, 0); __builtin_amdgcn_s_setprio(0); } while (0)
#define PG8_WAIT_V(n) asm volatile("s_waitcnt vmcnt(" #n ")" ::: "memory")
#define PG8_WAIT_L(n) asm volatile("s_waitcnt lgkmcnt(" #n ")" ::: "memory")
#define PG8_BAR __builtin_amdgcn_s_barrier()
#define PG8_SCHED __builtin_amdgcn_sched_barrier(0)
    Unit cur, nxt; int ui = 0;
    if (!S.next(0, cur)) return;
    f32x4 acc[2][2][4][2];
#pragma unroll
    for (int a = 0; a < 2; ++a)
#pragma unroll
        for (int b = 0; b < 2; ++b)
#pragma unroll
            for (int m = 0; m < 4; ++m)
#pragma unroll
                for (int n = 0; n < 2; ++n) acc[a][b][m][n] = (f32x4){0.f, 0.f, 0.f, 0.f};
    bf16x8 At[4][2], B0[2][2], B1[2][2];
    const char* cA = (const char*)g.A + (size_t)cur.pm * 2 * hA + (size_t)cur.ka * 2; const char* cB = (const char*)g.Bt + (size_t)cur.pn * 2 * hB + (size_t)cur.ka * 2;
    S.a_ready(cur);
    PG8_STAGE(PG8_SB(0, 0), cB, voffB); PG8_STAGE(PG8_SB(0, 1), cB + hB, voffB); PG8_STAGE(PG8_SA(0, 0), cA, voffA); PG8_STAGE(PG8_SA(0, 1), cA + hA, voffA);
    if (wr == 1) PG8_BAR;
    PG8_WAIT_V(2); PG8_BAR;
    PG8_STAGE(PG8_SB(1, 0), cB + kstep, voffB); PG8_STAGE(PG8_SA(1, 0), cA + kstep, voffA); PG8_STAGE(PG8_SB(1, 1), cB + hB + kstep, voffB);
    PG8_WAIT_V(6); PG8_BAR;
    for (;;) {
        const bool has_next = S.next(ui + 1, nxt);
        const char* nA = has_next ? (const char*)g.A + (size_t)nxt.pm * 2 * hA + (size_t)nxt.ka * 2 : cA; const char* nB = has_next ? (const char*)g.Bt + (size_t)nxt.pn * 2 * hB + (size_t)nxt.ka * 2 : cB;
        for (int t = 0; t < nt; t += 2) {
            const bool last = (t == nt - 2);
            const char* a1 = cA + (size_t)(t + 1) * kstep;
            const char* a2 = last ? nA : cA + (size_t)(t + 2) * kstep; const char* b2 = last ? nB : cB + (size_t)(t + 2) * kstep;
            const char* a3 = a2 + kstep; const char* b3 = b2 + kstep;
            if (last && has_next) S.a_ready(nxt);
            PG8_LDB(B0, 0, 0); PG8_LDB(B1, 0, 1); PG8_SCHED; PG8_LDA(At, 0, 0); PG8_STAGE(PG8_SA(1, 1), a1 + hA, voffA);
            PG8_WAIT_V(8); PG8_WAIT_L(0); PG8_BAR; PG8_MMA(0, 0, At, B0); PG8_MMA(0, 1, At, B1); PG8_BAR; PG8_SCHED;
            PG8_LDA(At, 0, 1); PG8_STAGE(PG8_SB(0, 0), b2, voffB); PG8_STAGE(PG8_SB(0, 1), b2 + hB, voffB); PG8_STAGE(PG8_SA(0, 0), a2, voffA);
            PG8_WAIT_V(8); PG8_WAIT_L(0); PG8_BAR; PG8_MMA(1, 0, At, B0); PG8_MMA(1, 1, At, B1); PG8_BAR; PG8_SCHED;
            PG8_LDB(B0, 1, 0); PG8_LDB(B1, 1, 1); PG8_SCHED; PG8_LDA(At, 1, 0); PG8_STAGE(PG8_SA(0, 1), a2 + hA, voffA);
            PG8_WAIT_V(8); PG8_WAIT_L(0); PG8_BAR; PG8_MMA(0, 0, At, B0); PG8_MMA(0, 1, At, B1); PG8_BAR; PG8_SCHED;
            PG8_LDA(At, 1, 1); PG8_STAGE(PG8_SB(1, 0), b3, voffB); PG8_STAGE(PG8_SB(1, 1), b3 + hB, voffB); PG8_STAGE(PG8_SA(1, 0), a3, voffA);
            PG8_WAIT_V(8); PG8_WAIT_L(0); PG8_BAR; PG8_MMA(1, 0, At, B0); PG8_MMA(1, 1, At, B1); PG8_BAR; PG8_SCHED;
        }
        if constexpr (ALIGN_EPI) { if (wr == 0) PG8_BAR; }
        E(acc, cur, wr, wc, fr, fq); S.done(cur);
        if (!has_next) break;
#pragma unroll
        for (int a = 0; a < 2; ++a)
#pragma unroll
            for (int b = 0; b < 2; ++b)
#pragma unroll
                for (int m = 0; m < 4; ++m)
#pragma unroll
                    for (int n = 0; n < 2; ++n) acc[a][b][m][n] = (f32x4){0.f, 0.f, 0.f, 0.f};
        cur = nxt; cA = nA; cB = nB; ++ui;
        if constexpr (ALIGN_EPI) { if (wr == 1) PG8_BAR; }
    }
    PG8_WAIT_V(0);
    if constexpr (!ALIGN_EPI) { if (wr == 0) PG8_BAR; }
    PG8_BAR;
#undef PG8_SA
#undef PG8_SB
#undef PG8_STAGE
#undef PG8_LDA
#undef PG8_LDB
#undef PG8_MMA
#undef PG8_WAIT_V
#undef PG8_WAIT_L
#undef PG8_BAR
#undef PG8_SCHED
}
}

#define XB_TMO      128
#define XB_XCNT(j)  (256  + 64 * (j))
#define XB_XSUB(j)  (1280 + 64 * (j))
#define XB_XGEN(j)  (2304 + 64 * (j))
#define XB_TOP      3328
#define XB_TOPGEN   3392
#define XCD_BAR_WORDS 3456
#define XB_SPIN_CAP (1u << 20)
__device__ __forceinline__ unsigned xb_ld(unsigned* p)              { return __hip_atomic_load(p, __ATOMIC_RELAXED, __HIP_MEMORY_SCOPE_AGENT); }
__device__ __forceinline__ unsigned xb_add(unsigned* p, unsigned v) { return __hip_atomic_fetch_add(p, v, __ATOMIC_RELAXED, __HIP_MEMORY_SCOPE_AGENT); }
__device__ __forceinline__ unsigned xb_xcc_id() { return (unsigned)__builtin_amdgcn_s_getreg((3 << 11) | 20) & 0xFu; }
#define XB_SPIN(cond, bar) do { unsigned _sp = 0; while (cond) { __builtin_amdgcn_s_sleep(1); \
    if ((++_sp & 255u) == 0u) { if (xb_ld(&(bar)[XB_TMO])) break; if (_sp > XB_SPIN_CAP) { atomicAdd(&(bar)[XB_TMO], 1u); break; } } } } while (0)
struct XcdBarrier { unsigned* bar; unsigned x; volatile LAS unsigned* st; };
__device__ __forceinline__ XcdBarrier xcd_barrier_post(unsigned* bar, volatile LAS unsigned* st) {
    XcdBarrier b; b.bar = bar; b.x = xb_xcc_id(); b.st = st;
    if (threadIdx.x == 0) (void)xb_add(&bar[XB_XCNT(b.x)], 1u);
    return b;
}
__device__ __forceinline__ void xcd_barrier_complete(unsigned* bar, unsigned x, unsigned& nloc, unsigned& nx) {
    const unsigned G = gridDim.x * gridDim.y * gridDim.z;
    unsigned sum, cnt, mine, sp = 0u;
    for (;;) {
        sum = 0u; cnt = 0u; mine = 0u;
#pragma unroll
        for (unsigned j = 0; j < 16; ++j) { const unsigned c = xb_ld(&bar[XB_XCNT(j)]); sum += c; cnt += (c > 0u) ? 1u : 0u; mine = (j == x) ? c : mine; }
        if (sum == G) break;
        __builtin_amdgcn_s_sleep(1);
        if ((++sp & 255u) == 0u) { if (xb_ld(&bar[XB_TMO])) break; if (sp > XB_SPIN_CAP) { atomicAdd(&bar[XB_TMO], 1u); break; } }
    }
    nloc = mine > 0u ? mine : 1u; nx = cnt > 0u ? cnt : 1u;
}
__device__ __forceinline__ void xcd_barrier(const XcdBarrier& b) {
    asm volatile("s_waitcnt vmcnt(0)" ::: "memory");
    __syncthreads();
    if (threadIdx.x == 0) {
        unsigned* bar = b.bar;
        __builtin_amdgcn_s_waitcnt(0);
        unsigned nloc = b.st[0], nx = b.st[1];
        if (nloc == 0u) { xcd_barrier_complete(bar, b.x, nloc, nx); b.st[0] = nloc; b.st[1] = nx; }
        const unsigned old = xb_add(&bar[XB_XSUB(b.x)], 1u);
        const unsigned gen = old / nloc;
        if (old + 1u == (gen + 1u) * nloc) {
            __builtin_amdgcn_fence(__ATOMIC_RELEASE, "agent");
            asm volatile("s_waitcnt vmcnt(0)" ::: "memory");
            const unsigned og = xb_add(&bar[XB_TOP], 1u);
            const unsigned tg = og / nx;
            if (og + 1u == (tg + 1u) * nx) xb_add(&bar[XB_TOPGEN], 1u);
            else XB_SPIN(xb_ld(&bar[XB_TOPGEN]) == tg, bar);
            __builtin_amdgcn_fence(__ATOMIC_ACQUIRE, "agent");
            xb_add(&bar[XB_XGEN(b.x)], 1u);
            asm volatile("s_waitcnt vmcnt(0)" ::: "memory");
        } else {
            XB_SPIN(xb_ld(&bar[XB_XGEN(b.x)]) == gen, bar);
            __builtin_amdgcn_fence(__ATOMIC_ACQUIRE, "agent");
            asm volatile("s_waitcnt vmcnt(0)" ::: "memory");
        }
    }
    __syncthreads();
}

constexpr int NWAVES = 8;
constexpr int RING_BYTES = 131072, MISC_OFF = RING_BYTES + 320, LDS_BYTES = 147456;
struct Params {
    const float* in[21]; float* out; unsigned char* ws; int ph_lo, ph_hi;
};
struct Frame {
    LAS unsigned char* lds; int tid, lane, wave, G, gw, ngw;
    const float *x, *w_in, *conv_w, *conv_b, *dt_bias, *a_log, *ssd_d, *norm_w, *f_bias, *gate_bias, *w_pssd, *w_patt, *w_out, *ln1_g, *ln1_b, *w_up, *fconv_w, *fconv_b, *w_down, *ln2_g, *ln2_b;
    float* out;
    bf16 *XB, *WIN, *WP, *WO, *WUP, *WD, *PROJ, *XACT, *AM, *MG, *H1B, *U, *ACT;
    float *DTF, *DTV, *LC, *CT, *SSQ, *M1, *H1;
};

__device__ __forceinline__ void transpose_item(const float* __restrict__ W, int N, int k0, int n0, bf16* dst, int ldt, const float* kscale, LAS float* scr, int lane) {
    float v[32];
#pragma unroll
    for (int i = 0; i < 32; ++i) { const int kk = 2 * i + (lane >> 5); v[i] = __builtin_nontemporal_load(W + (size_t)(k0 + kk) * N + n0 + (lane & 31)); }
    if (kscale) {
#pragma unroll
        for (int i = 0; i < 32; ++i) { const int kk = 2 * i + (lane >> 5); v[i] *= kscale[k0 + kk]; } }
#pragma unroll
    for (int i = 0; i < 32; ++i) { const int kk = 2 * i + (lane >> 5); scr[kk * 33 + (lane & 31)] = v[i]; }
    LDS_WAIT();
    const int c = lane & 7;
#pragma unroll
    for (int j = 0; j < 4; ++j) { const int n = (lane >> 3) + 8 * j; const LAS float* s = scr + (8 * c) * 33 + n;
        u32x4 o; o.x = cvt_pk_bf16(s[0 * 33], s[1 * 33]); o.y = cvt_pk_bf16(s[2 * 33], s[3 * 33]); o.z = cvt_pk_bf16(s[4 * 33], s[5 * 33]); o.w = cvt_pk_bf16(s[6 * 33], s[7 * 33]);
        *(u32x4*)(dst + (size_t)n * ldt + 8 * c) = o; }
    LDS_WAIT();
}
__device__ __forceinline__ int win_row(int n) {
    return n < OFF_DT ? n : (n < OFF_Q ? PSMALL + (n - OFF_DT) : (n < OFF_F ? n - 128 : (n < OFF_GS ? PSMALL + 128 + (n - OFF_F) : n - 160)));
}
__device__ __forceinline__ void p0_prologue(Frame& F) {
    LAS float* scr = (LAS float*)(F.lds + F.wave * 16384);
    constexpr int I_IN = (D_MODEL / 64) * (NPROJ / 32), I_PS = (D_INNER / 64) * (D_MODEL / 32), I_PA = (D_ATT / 64) * (D_MODEL / 32), I_O = (D_MODEL / 64) * (D_MODEL / 32);
    constexpr int I_UP = (D_MODEL / 64) * (2 * D_FF / 32), I_DN = (D_FF / 64) * (D_MODEL / 32);
    constexpr int NITEMS = I_IN + I_PS + I_PA + I_O + I_UP + I_DN;
    for (int it = F.gw; it < NITEMS; it += F.ngw) {
        int r = it;
        if (r < I_IN) { const int nb = NPROJ / 32, kb = r / nb, n0 = (r % nb) * 32; transpose_item(F.w_in, NPROJ, kb * 64, n0, F.WIN + (size_t)win_row(n0) * D_MODEL + kb * 64, D_MODEL, nullptr, scr, F.lane); continue; } r -= I_IN;
        if (r < I_PS) { const int nb = D_MODEL / 32, kb = r / nb, n0 = (r % nb) * 32; transpose_item(F.w_pssd, D_MODEL, kb * 64, n0, F.WP + (size_t)n0 * KM + kb * 64, KM, F.norm_w, scr, F.lane); continue; } r -= I_PS;
        if (r < I_PA) { const int nb = D_MODEL / 32, kb = r / nb, n0 = (r % nb) * 32; transpose_item(F.w_patt, D_MODEL, kb * 64, n0, F.WP + (size_t)n0 * KM + D_INNER + kb * 64, KM, nullptr, scr, F.lane); continue; } r -= I_PA;
        if (r < I_O) { const int nb = D_MODEL / 32, kb = r / nb, n0 = (r % nb) * 32; transpose_item(F.w_out, D_MODEL, kb * 64, n0, F.WO + (size_t)n0 * D_MODEL + kb * 64, D_MODEL, nullptr, scr, F.lane); continue; } r -= I_O;
        if (r < I_UP) { const int nb = 2 * D_FF / 32, kb = r / nb, n0 = (r % nb) * 32; transpose_item(F.w_up, 2 * D_FF, kb * 64, n0, F.WUP + (size_t)n0 * D_MODEL + kb * 64, D_MODEL, nullptr, scr, F.lane); continue; } r -= I_UP;
        { const int nb = D_MODEL / 32, kb = r / nb, n0 = (r % nb) * 32; transpose_item(F.w_down, D_MODEL, kb * 64, n0, F.WD + (size_t)n0 * D_FF + kb * 64, D_FF, nullptr, scr, F.lane); }
    }
    const size_t gt = (size_t)F.gw * 64 + F.lane, nth = (size_t)F.ngw * 64;
    for (size_t i = gt; i < (size_t)T * D_MODEL / 8; i += nth) { const f32x4 a = *(const f32x4*)(F.x + i * 8), b = *(const f32x4*)(F.x + i * 8 + 4);
        u32x4 w; w.x = cvt_pk_bf16(a[0], a[1]); w.y = cvt_pk_bf16(a[2], a[3]); w.z = cvt_pk_bf16(b[0], b[1]); w.w = cvt_pk_bf16(b[2], b[3]); *(u32x4*)(F.XB + i * 8) = w; }
}

__device__ __forceinline__ void unpack8(const u32x4 w, float (&v)[8]) { v[0] = bf_lo(w.x); v[1] = bf_hi(w.x); v[2] = bf_lo(w.y); v[3] = bf_hi(w.y); v[4] = bf_lo(w.z); v[5] = bf_hi(w.z); v[6] = bf_lo(w.w); v[7] = bf_hi(w.w); }
__device__ __forceinline__ void p2_conv_item(Frame& F, int item) {
    const int tb = item / 20, cb = item % 20, t0 = tb * 16, c0 = cb * 512 + F.lane * 8;
    const bool first = (t0 & (SEQ - 1)) == 0;
    const bf16* src = F.PROJ + (size_t)t0 * LDP + PXBC + c0;
    u32x4 rw[19];
#pragma unroll
    for (int i = 0; i < 3; ++i) rw[i] = first ? (u32x4){0u, 0u, 0u, 0u} : *(const u32x4*)(src - (3 - i) * (size_t)LDP);
#pragma unroll
    for (int i = 0; i < 16; ++i) rw[3 + i] = *(const u32x4*)(src + (size_t)i * LDP);
    float w[4][8], bs[8];
#pragma unroll
    for (int k = 0; k < 4; ++k) { const f32x4 a = *(const f32x4*)(F.conv_w + k * CONV_DIM + c0), b = *(const f32x4*)(F.conv_w + k * CONV_DIM + c0 + 4);
#pragma unroll
        for (int j = 0; j < 4; ++j) { w[k][j] = a[j]; w[k][4 + j] = b[j]; } }
    { const f32x4 a = *(const f32x4*)(F.conv_b + c0), b = *(const f32x4*)(F.conv_b + c0 + 4);
#pragma unroll
      for (int j = 0; j < 4; ++j) { bs[j] = a[j]; bs[4 + j] = b[j]; } }
    float x0[8], x1[8], x2[8], x3[8];
    unpack8(rw[0], x0); unpack8(rw[1], x1); unpack8(rw[2], x2);
#pragma unroll
    for (int i = 0; i < 16; ++i) {
        unpack8(rw[3 + i], x3);
        float o[8];
#pragma unroll
        for (int j = 0; j < 8; ++j) { float a = bs[j]; a = fmaf(w[0][j], x0[j], a); a = fmaf(w[1][j], x1[j], a); a = fmaf(w[2][j], x2[j], a); a = fmaf(w[3][j], x3[j], a); o[j] = silu_f(a); x0[j] = x1[j]; x1[j] = x2[j]; x2[j] = x3[j]; }
        u32x4 q; q.x = cvt_pk_bf16(o[0], o[1]); q.y = cvt_pk_bf16(o[2], o[3]); q.z = cvt_pk_bf16(o[4], o[5]); q.w = cvt_pk_bf16(o[6], o[7]);
        *(u32x4*)(F.XACT + (size_t)(t0 + i) * CONV_DIM + c0) = q;
    }
}
__device__ __forceinline__ void p2_dt_item(Frame& F, int item) {
#pragma unroll
    for (int j = 0; j < 8; ++j) { const int e = item * 512 + j * 64 + F.lane, t = e >> 7, h = e & 127; float s = 0.f;
#pragma unroll
        for (int ks = 0; ks < NSLAB; ++ks) s += F.DTF[((size_t)ks * T + t) * 256 + h];
        F.DTV[(size_t)t * SSD_H + h] = softplus_f(s + F.dt_bias[h]); }
}
__device__ __forceinline__ void p2_fcum_item(Frame& F, int item) {
    const int b = item >> 6, c = item & 63, t = b * SEQ + c * 64 + F.lane;
#pragma unroll 1
    for (int h4 = 0; h4 < FOX_H; h4 += 4) {
        f32x4 s = (f32x4){0.f, 0.f, 0.f, 0.f};
#pragma unroll
        for (int ks = 0; ks < NSLAB; ++ks) s += *(const f32x4*)(F.DTF + ((size_t)ks * T + t) * 256 + 128 + h4);
#pragma unroll
        for (int j = 0; j < 4; ++j) { float v = logsigmoid_f(s[j] + F.f_bias[h4 + j]);
#pragma unroll
            for (int o = 1; o < 64; o <<= 1) { const float u = __shfl_up(v, o); if (F.lane >= o) v += u; }
            F.LC[(size_t)(b * FOX_H + h4 + j) * SEQ + c * 64 + F.lane] = v;
            if (F.lane == 63) F.CT[(b * FOX_H + h4 + j) * 64 + c] = v; }
    }
}
__device__ __forceinline__ void p2_prep(Frame& F) {
    constexpr int N_FC = BATCH * 64, N_CONV = (T / 16) * 20, N_DT = T * SSD_H / 512;
    for (int it = F.gw; it < N_FC + N_CONV + N_DT; it += F.ngw) {
        if (it < N_FC) p2_fcum_item(F, it); else if (it < N_FC + N_CONV) p2_conv_item(F, it - N_FC); else p2_dt_item(F, it - N_FC - N_CONV);
    }
}

__device__ __forceinline__ void p5_norm(Frame& F) {
    for (int t = F.gw; t < T; t += F.ngw) {
        const f32x4 q = *(const f32x4*)(F.SSQ + (size_t)t * 256 + F.lane * 4);
        float s0 = (q[0] + q[1]) + (q[2] + q[3]);
#pragma unroll
        for (int o = 1; o < 8; o <<= 1) s0 += __shfl_xor(s0, o);
        const float r0 = rsqrtf(s0 * (1.f / 1024.f) + RMS_EPS);
        bf16* row = F.AM + (size_t)t * KM + F.lane * 8;
        u32x4 rw[16];
#pragma unroll
        for (int j = 0; j < 16; ++j) rw[j] = *(const u32x4*)(row + j * 512);
#pragma unroll
        for (int j = 0; j < 16; ++j) { const int g = j >> 1; const float r = __shfl(r0, g * 8);
            u32x4 w = rw[j]; float v[8]; unpack8(w, v);
            w.x = cvt_pk_bf16(v[0] * r, v[1] * r); w.y = cvt_pk_bf16(v[2] * r, v[3] * r); w.z = cvt_pk_bf16(v[4] * r, v[5] * r); w.w = cvt_pk_bf16(v[6] * r, v[7] * r);
            *(u32x4*)(row + j * 512) = w; }
    }
}

__device__ __forceinline__ float wave_sum(float v) {
#pragma unroll
    for (int o = 1; o < 64; o <<= 1) v += __shfl_xor(v, o);
    return v;
}
template <bool WITH_BF16> __device__ __forceinline__ void ln_rows(Frame& F, const float* src, const float* g, const float* b, float* dst, bf16* dstb) {
    f32x4 nx[16];
    if (F.gw < T) { const f32x4* xr = (const f32x4*)(src + (size_t)F.gw * D_MODEL) + F.lane;
#pragma unroll
        for (int j = 0; j < 16; ++j) nx[j] = xr[64 * j]; }
    for (int t = F.gw; t < T; t += F.ngw) {
        f32x4 v[16]; float s = 0.f;
#pragma unroll
        for (int j = 0; j < 16; ++j) { v[j] = nx[j]; s += (v[j][0] + v[j][1]) + (v[j][2] + v[j][3]); }
        if (t + F.ngw < T) { const f32x4* xr = (const f32x4*)(src + (size_t)(t + F.ngw) * D_MODEL) + F.lane;
#pragma unroll
            for (int j = 0; j < 16; ++j) nx[j] = xr[64 * j]; }
        const float mean = wave_sum(s) * (1.f / D_MODEL); float q = 0.f;
#pragma unroll
        for (int j = 0; j < 16; ++j) { v[j] = v[j] - mean; q += (v[j][0] * v[j][0] + v[j][1] * v[j][1]) + (v[j][2] * v[j][2] + v[j][3] * v[j][3]); }
        const float rstd = rsqrtf(wave_sum(q) * (1.f / D_MODEL) + LN_EPS);
#pragma unroll
        for (int j = 0; j < 16; ++j) { const int c = (64 * j + F.lane) * 4; const f32x4 gg = *(const f32x4*)(g + c), bb = *(const f32x4*)(b + c); const f32x4 o = v[j] * rstd * gg + bb;
            *(f32x4*)(dst + (size_t)t * D_MODEL + c) = o;
            if (WITH_BF16) { u32x2 w; w.x = cvt_pk_bf16(o[0], o[1]); w.y = cvt_pk_bf16(o[2], o[3]); *(u32x2*)(dstb + (size_t)t * D_MODEL + c) = w; } }
    }
}

__device__ __forceinline__ void p11_act_item(Frame& F, int item) {
    const int tb = item / 43, cb = item % 43, t0 = tb * 16, c0 = cb * 256 + F.lane * 4;
    const bool first = (t0 & (SEQ - 1)) == 0;
    const bf16* src = F.U + (size_t)t0 * (2 * D_FF) + c0;
    u32x2 rv[18], rg[18];
#pragma unroll
    for (int i = 0; i < 2; ++i) { rv[i] = first ? (u32x2){0u, 0u} : *(const u32x2*)(src - (2 - i) * (size_t)(2 * D_FF)); rg[i] = first ? (u32x2){0u, 0u} : *(const u32x2*)(src - (2 - i) * (size_t)(2 * D_FF) + D_FF); }
#pragma unroll
    for (int i = 0; i < 16; ++i) { rv[2 + i] = *(const u32x2*)(src + (size_t)i * (2 * D_FF)); rg[2 + i] = *(const u32x2*)(src + (size_t)i * (2 * D_FF) + D_FF); }
    f32x4 wv[3], wg[3];
#pragma unroll
    for (int k = 0; k < 3; ++k) { wv[k] = *(const f32x4*)(F.fconv_w + k * 2 * D_FF + c0); wg[k] = *(const f32x4*)(F.fconv_w + k * 2 * D_FF + D_FF + c0); }
    const f32x4 bv = *(const f32x4*)(F.fconv_b + c0), bg = *(const f32x4*)(F.fconv_b + D_FF + c0);
    auto up4 = [](const u32x2 w) { return (f32x4){bf_lo(w.x), bf_hi(w.x), bf_lo(w.y), bf_hi(w.y)}; };
    f32x4 v0 = up4(rv[0]), v1 = up4(rv[1]), g0 = up4(rg[0]), g1 = up4(rg[1]);
#pragma unroll
    for (int i = 0; i < 16; ++i) {
        const f32x4 v2 = up4(rv[2 + i]), g2 = up4(rg[2 + i]);
        const f32x4 cv = bv + wv[0] * v0 + wv[1] * v1 + wv[2] * v2, cg = bg + wg[0] * g0 + wg[1] * g1 + wg[2] * g2;
        u32x2 w; w.x = cvt_pk_bf16(silu_f(cg[0]) * cv[0], silu_f(cg[1]) * cv[1]); w.y = cvt_pk_bf16(silu_f(cg[2]) * cv[2], silu_f(cg[3]) * cv[3]);
        *(u32x2*)(F.ACT + (size_t)(t0 + i) * D_FF + c0) = w;
        v0 = v1; v1 = v2; g0 = g1; g1 = g2;
    }
}

namespace ssd {
typedef float f32x16 __attribute__((ext_vector_type(16)));
typedef LAS char* lptr;
constexpr int PCM = 272, PBM = 272, PBT = 144, PXT = 144, PHB = 272;
constexpr int O_CM = 0, O_BM = O_CM + 64 * PCM, O_BT = O_BM + 64 * PBM, O_XT = O_BT + 128 * PBT, O_HB = O_XT + 64 * PXT, O_VEC = O_HB + 64 * PHB, SSD_LDS = O_VEC + 1024;
constexpr int V_DT = 0, V_ACS = 256, V_W = 512, V_E = 768;
__device__ __forceinline__ int crow(int r, int hi) { return (r & 3) + 8 * (r >> 2) + 4 * hi; }
__device__ __forceinline__ void tr_block_write(const u32x4 (&blk)[8], lptr base, int pitch, int cg, int tg) {
#pragma unroll
    for (int j = 0; j < 8; ++j) {
        u32x4 o;
#pragma unroll
        for (int m = 0; m < 4; ++m) { const unsigned a = blk[2 * m][j >> 1], b = blk[2 * m + 1][j >> 1];
            o[m] = (j & 1) ? ((a >> 16) | (b & 0xffff0000u)) : ((a & 0xffffu) | (b << 16)); }
        *(LAS u32x4*)(base + (cg * 8 + j) * pitch + tg * 16) = o;
    }
}
struct Pre { u32x4 nat[4]; u32x4 blk[8]; float dtr; };
__device__ __forceinline__ void loads(Pre& P, const bf16* XACT, const float* DTV, size_t t0, int h, int g, int tid, int wid, int lane) {
    const int rowA = tid >> 4, ch = tid & 15;
    const bf16* cm = XACT + (t0 + rowA) * CONV_DIM + D_INNER + SSD_G * SSD_N + g * SSD_N + ch * 8;
    const bf16* bm = XACT + (t0 + rowA) * CONV_DIM + D_INNER + g * SSD_N + ch * 8;
    P.nat[0] = *(const u32x4*)cm; P.nat[1] = *(const u32x4*)(cm + 32 * (size_t)CONV_DIM); P.nat[2] = *(const u32x4*)bm; P.nat[3] = *(const u32x4*)(bm + 32 * (size_t)CONV_DIM);
    if (wid == 4) { const int cg = lane >> 3, tg = lane & 7; const bf16* p = XACT + (t0 + tg * 8) * CONV_DIM + h * SSD_P + cg * 8;
#pragma unroll
        for (int i = 0; i < 8; ++i) P.blk[i] = *(const u32x4*)(p + (size_t)i * CONV_DIM); }
    else if (wid == 5 || wid == 6) { const int idx = (wid - 5) * 64 + lane, cg = idx >> 3, tg = idx & 7; const bf16* p = XACT + (t0 + tg * 8) * CONV_DIM + D_INNER + g * SSD_N + cg * 8;
#pragma unroll
        for (int i = 0; i < 8; ++i) P.blk[i] = *(const u32x4*)(p + (size_t)i * CONV_DIM); }
    else if (wid == 7) P.dtr = DTV[(t0 + lane) * SSD_H + h];
}
__device__ __forceinline__ bf16x8 pack8f(const float (&v)[8]) { u32x4 w = {cvt_pk_bf16(v[0], v[1]), cvt_pk_bf16(v[2], v[3]), cvt_pk_bf16(v[4], v[5]), cvt_pk_bf16(v[6], v[7])}; return *reinterpret_cast<bf16x8*>(&w); }
__device__ __forceinline__ void phase(lptr lds, const bf16* PROJ, const bf16* XACT, const float* DTV, const float* a_log, const float* dskip, bf16* AM, float* SSQ, int G, int bx) {
    const int tid = threadIdx.x, wid = __builtin_amdgcn_readfirstlane(tid >> 6), lane = tid & 63, r32 = lane & 31, hi = lane >> 5;
    const LAS float* vec = (const LAS float*)(lds + O_VEC);
    for (int bh = bx; bh < BATCH * SSD_H; bh += G) {
        const int b = bh / SSD_H, h = bh % SSD_H, g = h / SSD_R;
        const float a = -__expf(a_log[h]), dsk = dskip[h];
        const size_t row0 = (size_t)b * SEQ;
        f32x16 st = {};
        Pre P;
        loads(P, XACT, DTV, row0, h, g, tid, wid, lane);
        for (int c = 0; c < SEQ / 64; ++c) {
            const size_t t0 = row0 + (size_t)c * 64;
            { const int rowA = tid >> 4, ch = tid & 15;
              *(LAS u32x4*)(lds + O_CM + rowA * PCM + ch * 16) = P.nat[0]; *(LAS u32x4*)(lds + O_CM + (rowA + 32) * PCM + ch * 16) = P.nat[1];
              *(LAS u32x4*)(lds + O_BM + rowA * PBM + ch * 16) = P.nat[2]; *(LAS u32x4*)(lds + O_BM + (rowA + 32) * PBM + ch * 16) = P.nat[3]; }
            if (wid == 4) tr_block_write(P.blk, lds + O_XT, PXT, lane >> 3, lane & 7);
            else if (wid == 5 || wid == 6) { const int idx = (wid - 5) * 64 + lane; tr_block_write(P.blk, lds + O_BT, PBT, idx >> 3, idx & 7); }
            else if (wid == 7) { const float dtv = P.dtr; float acs = dtv * a;
#pragma unroll
                for (int o = 1; o < 64; o <<= 1) { const float u = __shfl_up(acs, o); if (lane >= o) acs += u; }
                const float a63 = __shfl(acs, 63);
                LAS float* vw = (LAS float*)(lds + O_VEC);
                vw[V_DT / 4 + lane] = dtv; vw[V_ACS / 4 + lane] = acs; vw[V_W / 4 + lane] = __expf(a63 - acs) * dtv; vw[V_E / 4 + lane] = __expf(acs); }
            { const int nt = wid & 3, pt = wid >> 2; lptr hb = lds + O_HB + (32 * pt + r32) * PHB + (32 * nt + 4 * hi) * 2;
#pragma unroll
              for (int q = 0; q < 4; ++q) { u32x2 w; w.x = cvt_pk_bf16(st[4 * q], st[4 * q + 1]); w.y = cvt_pk_bf16(st[4 * q + 2], st[4 * q + 3]); *(LAS u32x2*)(hb + 16 * q) = w; } }
            LDS_WAIT(); __syncthreads();
            if (c + 1 < SEQ / 64) loads(P, XACT, DTV, t0 + 64, h, g, tid, wid, lane);
            if (wid < 4) {
                const int lt = wid & 1, pt2 = wid >> 1;
                const bf16* zp = PROJ + (t0 + 32 * lt + r32) * LDP + PZ + h * SSD_P + 32 * pt2 + 4 * hi;
                u32x2 zr[4];
#pragma unroll
                for (int q = 0; q < 4; ++q) zr[q] = *(const u32x2*)(zp + 8 * q);
                const float acsl = vec[V_ACS / 4 + 32 * lt + r32];
                bf16x8 gf[2][2];
                const lptr cmrow = lds + O_CM + (32 * lt + r32) * PCM + hi * 16;
#pragma unroll
                for (int s_ = 0; s_ < 2; ++s_) if (s_ <= lt) {
                    f32x16 cb = {};
                    const lptr bmrow = lds + O_BM + (32 * s_ + r32) * PBM + hi * 16;
#pragma unroll
                    for (int kk = 0; kk < 8; ++kk) cb = __builtin_amdgcn_mfma_f32_32x32x16_bf16(*(const LAS bf16x8*)(bmrow + kk * 32), *(const LAS bf16x8*)(cmrow + kk * 32), cb, 0, 0, 0);
                    float gv[16];
#pragma unroll
                    for (int q = 0; q < 4; ++q) { const f32x4 as4 = *(const LAS f32x4*)(vec + V_ACS / 4 + 32 * s_ + 8 * q + 4 * hi), dt4 = *(const LAS f32x4*)(vec + V_DT / 4 + 32 * s_ + 8 * q + 4 * hi);
#pragma unroll
                        for (int e = 0; e < 4; ++e) { const int srow = 32 * s_ + 8 * q + 4 * hi + e; gv[4 * q + e] = (srow <= 32 * lt + r32) ? cb[4 * q + e] * __expf(acsl - as4[e]) * dt4[e] : 0.f; } }
                    { float t8[8];
#pragma unroll
                      for (int e = 0; e < 8; ++e) t8[e] = gv[e];
                      gf[s_][0] = pack8f(t8);
#pragma unroll
                      for (int e = 0; e < 8; ++e) t8[e] = gv[8 + e];
                      gf[s_][1] = pack8f(t8); }
                }
                f32x16 y = {};
                { const lptr hbrow = lds + O_HB + (32 * pt2 + r32) * PHB + hi * 16;
#pragma unroll
                  for (int kk = 0; kk < 8; ++kk) y = __builtin_amdgcn_mfma_f32_32x32x16_bf16(*(const LAS bf16x8*)(hbrow + kk * 32), *(const LAS bf16x8*)(cmrow + kk * 32), y, 0, 0, 0); }
                { const float el = vec[V_E / 4 + 32 * lt + r32];
#pragma unroll
                  for (int r = 0; r < 16; ++r) y[r] *= el; }
                const lptr xtrow = lds + O_XT + (32 * pt2 + r32) * PXT + hi * 8;
#pragma unroll
                for (int s_ = 0; s_ < 2; ++s_) if (s_ <= lt) {
#pragma unroll
                    for (int s2 = 0; s2 < 2; ++s2) { const u32x2 lo = *(const LAS u32x2*)(xtrow + (32 * s_ + 16 * s2) * 2), hi2 = *(const LAS u32x2*)(xtrow + (32 * s_ + 16 * s2 + 8) * 2);
                        u32x4 aw = {lo.x, lo.y, hi2.x, hi2.y};
                        y = __builtin_amdgcn_mfma_f32_32x32x16_bf16(*reinterpret_cast<bf16x8*>(&aw), gf[s_][s2], y, 0, 0, 0); }
                }
                float ss = 0.f;
                bf16* op = AM + (t0 + 32 * lt + r32) * KM + h * SSD_P + 32 * pt2 + 4 * hi;
#pragma unroll
                for (int q = 0; q < 4; ++q) { float o4[4];
#pragma unroll
                    for (int e = 0; e < 4; ++e) { const int p = 32 * pt2 + 8 * q + 4 * hi + e; const float xs = bf2f(*(const LAS bf16*)(lds + O_XT + p * PXT + (32 * lt + r32) * 2));
                        const float zv = (e & 1) ? bf_hi(e < 2 ? zr[q].x : zr[q].y) : bf_lo(e < 2 ? zr[q].x : zr[q].y);
                        const float ov = (y[4 * q + e] + dsk * xs) * silu_f(zv); o4[e] = ov; ss += ov * ov; }
                    u32x2 w; w.x = cvt_pk_bf16(o4[0], o4[1]); w.y = cvt_pk_bf16(o4[2], o4[3]); *(u32x2*)(op + 8 * q) = w; }
                ss += __shfl_xor(ss, 32);
                if (hi == 0) SSQ[(t0 + 32 * lt + r32) * 256 + h * 2 + pt2] = ss;
            }
            { const int nt = wid & 3, pt = wid >> 2; const float cdec = vec[V_E / 4 + 63];
#pragma unroll
              for (int r = 0; r < 16; ++r) st[r] *= cdec;
              const lptr btrow = lds + O_BT + (32 * nt + r32) * PBT + hi * 16; const lptr xtrow = lds + O_XT + (32 * pt + r32) * PXT + hi * 16;
#pragma unroll
              for (int ks = 0; ks < 4; ++ks) { const u32x4 xr = *(const LAS u32x4*)(xtrow + ks * 32);
                  const f32x4 w0 = *(const LAS f32x4*)(vec + V_W / 4 + 16 * ks + 8 * hi), w1 = *(const LAS f32x4*)(vec + V_W / 4 + 16 * ks + 8 * hi + 4);
                  float xv[8]; unpack8(xr, xv);
#pragma unroll
                  for (int e = 0; e < 4; ++e) { xv[e] *= w0[e]; xv[4 + e] *= w1[e]; }
                  st = __builtin_amdgcn_mfma_f32_32x32x16_bf16(*(const LAS bf16x8*)(btrow + ks * 32), pack8f(xv), st, 0, 0, 0); } }
            LDS_WAIT(); __syncthreads();
        }
    }
}
}

namespace fox {
constexpr float SCALE = 0.08838834764831845f;
constexpr int NW = 8, QBLK = 32, KVBLK = 64, QB = NW * QBLK, D = 128;
constexpr int SHM_V = KVBLK * D * 2, SHM_K = KVBLK * D * 2;
constexpr int OFF_WS = 2 * SHM_V + 2 * SHM_K, OFF_BL = OFF_WS + NW * 64 * 4, OFF_PREF = OFF_BL + SEQ * 4, ATTN_LDS = OFF_PREF + 256;
constexpr float THR = 8.f;
typedef short s16x4 __attribute__((ext_vector_type(4)));
typedef float f32x16 __attribute__((ext_vector_type(16)));
typedef LAS char* lptr;
#define KSWZ(row, colB) ((row) * 256 + ((colB) ^ (((row) & 7) << 4)))
#define SBAR() __builtin_amdgcn_sched_barrier(0)
__device__ __forceinline__ int v_st(int k, int c) { const int kk = (k & ~0xC) | ((k & 4) << 1) | ((k & 8) >> 1); return ((kk >> 3) * 4 + (c >> 5)) * 512 + ((kk & 7) * 32 + (c & 31)) * 2; }
__device__ __forceinline__ int v_rd_base(int lane) { return ((lane & 3) << 3) | (((lane >> 2) & 3) << 6) | (((lane >> 4) & 1) << 5) | (((lane >> 5) & 1) << 8); }
constexpr int v_rd_off(int d0, int ks, int half) { return d0 * 512 + ks * 4096 + half * 2048; }
__device__ __forceinline__ int crow(int r, int hi) { return (r & 3) + 8 * (r >> 2) + 4 * hi; }
__device__ __forceinline__ bf16x8 ld8(const bf16* p) { return *reinterpret_cast<const bf16x8*>(p); }
__device__ __forceinline__ void mask_tile(f32x16& p0, f32x16& p1, int dq) {
    const float NEG = -__builtin_inff();
#pragma unroll
    for (int r = 0; r < 16; ++r) { const int c = (r & 3) + 8 * (r >> 2); if (dq - c < 0) p0[r] = NEG; if (dq - c - 32 < 0) p1[r] = NEG; }
}
__device__ __forceinline__ void partialSM(f32x16& p0, f32x16& p1, float& m_reg, float& mn, float& alpha) {
    float pmax = p0[0];
#pragma unroll
    for (int r = 1; r < 16; ++r) pmax = fmaxf(pmax, p0[r]);
#pragma unroll
    for (int r = 0; r < 16; ++r) pmax = fmaxf(pmax, p1[r]);
    { auto rr = __builtin_amdgcn_permlane32_swap(__float_as_uint(pmax), __float_as_uint(pmax), false, false); pmax = fmaxf(__uint_as_float(rr[0]), __uint_as_float(rr[1])); }
    constexpr float C2 = 1.4426950408889634f * SCALE;
    if (__builtin_expect(__all((pmax - m_reg) * SCALE <= THR), 1)) { mn = m_reg; alpha = 1.f; }
    else { mn = fmaxf(m_reg, pmax); alpha = __builtin_amdgcn_exp2f((m_reg - mn) * C2); m_reg = mn; }
    const float mnL = -mn * C2;
#pragma unroll
    for (int r = 0; r < 16; ++r) p0[r] = fmaf(p0[r], C2, mnL);
#pragma unroll
    for (int r = 0; r < 16; ++r) p1[r] = fmaf(p1[r], C2, mnL);
#pragma unroll
    for (int r = 0; r < 16; ++r) p0[r] = __builtin_amdgcn_exp2f(p0[r]);
}
__device__ __forceinline__ void finishSM(f32x16& p0, f32x16& p1, float alpha, float& l_reg, bf16x8& pa0, bf16x8& pa1, bf16x8& pa2, bf16x8& pa3) {
#pragma unroll
    for (int r = 0; r < 16; ++r) p1[r] = __builtin_amdgcn_exp2f(p1[r]);
    float ps = 0;
#pragma unroll
    for (int r = 0; r < 16; ++r) ps += p0[r];
#pragma unroll
    for (int r = 0; r < 16; ++r) ps += p1[r];
    { auto rr = __builtin_amdgcn_permlane32_swap(__float_as_uint(ps), __float_as_uint(ps), false, false); ps = __uint_as_float(rr[0]) + __uint_as_float(rr[1]); }
    l_reg = l_reg * alpha + ps;
#define PK4(P, B_, OUT) do { unsigned a0 = cvt_pk_bf16(P[B_+0], P[B_+1]), a1 = cvt_pk_bf16(P[B_+2], P[B_+3]);                          \
        unsigned b0 = cvt_pk_bf16(P[B_+4], P[B_+5]), b1 = cvt_pk_bf16(P[B_+6], P[B_+7]);                                             \
        auto r0 = __builtin_amdgcn_permlane32_swap(a0, b0, false, false); auto r1 = __builtin_amdgcn_permlane32_swap(a1, b1, false, false); \
        u32x4 w = {r0[0], r1[0], r0[1], r1[1]}; OUT = *reinterpret_cast<bf16x8*>(&w); } while (0)
    PK4(p0, 0, pa0); PK4(p0, 8, pa1); PK4(p1, 0, pa2); PK4(p1, 8, pa3);
#undef PK4
}
template <int KB>
__device__ __forceinline__ void qkt(f32x16& p0, f32x16& p1, lptr K_lds, int r32, int hi, const bf16x8* qr, const LAS float* blk) {
    { const LAS f32x4* bp = (const LAS f32x4*)blk;
      const f32x4 a0 = bp[0], a1 = bp[2], a2 = bp[4], a3 = bp[6], c0 = bp[8], c1 = bp[10], c2 = bp[12], c3 = bp[14];
      p0 = (f32x16){a0[0], a0[1], a0[2], a0[3], a1[0], a1[1], a1[2], a1[3], a2[0], a2[1], a2[2], a2[3], a3[0], a3[1], a3[2], a3[3]};
      p1 = (f32x16){c0[0], c0[1], c0[2], c0[3], c1[0], c1[1], c1[2], c1[3], c2[0], c2[1], c2[2], c2[3], c3[0], c3[1], c3[2], c3[3]}; }
    lptr kb[4];
#pragma unroll
    for (int dd = 0; dd < 4; ++dd) kb[dd] = K_lds + KB * SHM_K + KSWZ(r32, (dd * 16 + hi * 8) * 2);
#pragma unroll
    for (int d0 = 0; d0 < 8; ++d0) { lptr a = kb[d0 & 3] + (d0 >> 2) * 128;
        bf16x8 b0 = *(const LAS bf16x8*)(a);
        bf16x8 b1 = *(const LAS bf16x8*)(a + 32 * 256);
        p0 = __builtin_amdgcn_mfma_f32_32x32x16_bf16(b0, qr[d0], p0, 0, 0, 0);
        p1 = __builtin_amdgcn_mfma_f32_32x32x16_bf16(b1, qr[d0], p1, 0, 0, 0); }
}
template <int VB>
__device__ __forceinline__ void pv_tile(f32x16* o, int vb0, bf16x8 pa0, bf16x8 pa1, bf16x8 pa2, bf16x8 pa3) {
#define TRRD(dst, off) asm volatile("ds_read_b64_tr_b16 %0, %1 offset:%2" : "=&v"(dst) : "v"(vb0), "i"(off) : "memory")
#define PV_D0(d0) do { s16x4 l0, l1, l2, l3, h0, h1, h2, h3; constexpr int b_ = VB * SHM_V + v_rd_off(d0, 0, 0); \
        TRRD(l0, b_); TRRD(h0, b_ + 2048); TRRD(l1, b_ + 4096); TRRD(h1, b_ + 6144); TRRD(l2, b_ + 8192); TRRD(h2, b_ + 10240); TRRD(l3, b_ + 12288); TRRD(h3, b_ + 14336); \
        asm volatile("s_waitcnt lgkmcnt(0)" ::: "memory"); SBAR();   \
        o[d0] = __builtin_amdgcn_mfma_f32_32x32x16_bf16(pa0, (bf16x8){l0[0], l0[1], l0[2], l0[3], h0[0], h0[1], h0[2], h0[3]}, o[d0], 0, 0, 0);   \
        o[d0] = __builtin_amdgcn_mfma_f32_32x32x16_bf16(pa1, (bf16x8){l1[0], l1[1], l1[2], l1[3], h1[0], h1[1], h1[2], h1[3]}, o[d0], 0, 0, 0);   \
        o[d0] = __builtin_amdgcn_mfma_f32_32x32x16_bf16(pa2, (bf16x8){l2[0], l2[1], l2[2], l2[3], h2[0], h2[1], h2[2], h2[3]}, o[d0], 0, 0, 0);   \
        o[d0] = __builtin_amdgcn_mfma_f32_32x32x16_bf16(pa3, (bf16x8){l3[0], l3[1], l3[2], l3[3], h3[0], h3[1], h3[2], h3[3]}, o[d0], 0, 0, 0); } while (0)
    PV_D0(0); PV_D0(1); PV_D0(2); PV_D0(3);
#undef PV_D0
#undef TRRD
}
struct BlockRef { const bf16* Q; const bf16* K; const bf16* V; bf16* O; int P0; };
struct Seam { bf16x8 qr[8]; bf16x8 st_v0, st_v1, st_k0, st_k1; };
#define ROWB(p, k0, half) ((const char*)((p) + (size_t)(k0) * LDP) + ((half) ? voff1 : voff0))
#define VMW() asm volatile("s_waitcnt vmcnt(0)" ::: "memory")
#define VMWN(n) asm volatile("s_waitcnt vmcnt(%0)" :: "i"(n) : "memory")
#define SLOAD_H(Kp, Vp, k0) do { S.st_v0 = ld8((const bf16*)ROWB(Vp, k0, 0)); S.st_v1 = ld8((const bf16*)ROWB(Vp, k0, 1)); S.st_k0 = ld8((const bf16*)ROWB(Kp, k0, 0)); S.st_k1 = ld8((const bf16*)ROWB(Kp, k0, 1)); } while (0)
#define SWRITE_HK(bf) do { *(LAS bf16x8*)(K_lds + (bf) * SHM_K + kws) = S.st_k0; *(LAS bf16x8*)(K_lds + (bf) * SHM_K + kws + 32 * 256) = S.st_k1; } while (0)
#define SWRITE_HV(bf) do { *(LAS bf16x8*)(V_lds + (bf) * SHM_V + vst0) = S.st_v0; *(LAS bf16x8*)(V_lds + (bf) * SHM_V + vst1) = S.st_v1; } while (0)
#define SWRITE_H(bf) do { SWRITE_HV(bf); SWRITE_HK(bf); } while (0)
__device__ __forceinline__ void prime(const BlockRef& cur, lptr lds, Seam& S) {
    const int tid = threadIdx.x, wid = __builtin_amdgcn_readfirstlane(tid >> 6), lane = tid & 63, r32 = lane & 31, hi = lane >> 5;
    const int sr = tid >> 4, sc = (tid & 15) * 8, kws = KSWZ(sr, sc * 2); lptr K_lds = lds + 2 * SHM_V;
    const unsigned voff0 = (unsigned)(sr * LDP + sc) * 2u, voff1 = voff0 + 32u * LDP * 2u;
#pragma unroll
    for (int d0 = 0; d0 < 8; ++d0) S.qr[d0] = ld8((const bf16*)((const char*)cur.Q + (unsigned)((wid * QBLK + r32) * LDP + hi * 8) * 2u + d0 * 32));
    SLOAD_H(cur.K, cur.V, 0); VMW(); SWRITE_HK(0);
    __syncthreads();
}
__device__ __forceinline__ void block(const BlockRef& cur, const BlockRef& nxt, lptr lds, Seam& S) {
    const int tid = threadIdx.x, wid = __builtin_amdgcn_readfirstlane(tid >> 6), lane = tid & 63, r32 = lane & 31, hi = lane >> 5;
    const int NT = (cur.P0 + QB) / KVBLK;
    const int qlo = cur.P0 + wid * QBLK, qm = qlo + r32 - 4 * hi;
    lptr V_lds = lds; lptr K_lds = lds + 2 * SHM_V;
    LAS float* ws = (LAS float*)(lds + OFF_WS) + wid * 64; LAS float* li_l = ws; LAS float* al_l = ws + 32;
    const LAS float* bl = (const LAS float*)(lds + OFF_BL) + 4 * hi;
    float m_reg = -1e30f, l_reg = 0; f32x16 o[4] = {};
    const int sr = tid >> 4, sc = (tid & 15) * 8, vst0 = v_st(sr, sc), vst1 = v_st(32 + sr, sc), kws = KSWZ(sr, sc * 2);
    const unsigned voff0 = (unsigned)(sr * LDP + sc) * 2u, voff1 = voff0 + 32u * LDP * 2u;
    const int vb0 = (int)(unsigned)(uintptr_t)V_lds + v_rd_base(lane);
    const bf16* Kh = cur.K; const bf16* Vh = cur.V;
#define RESC(a) do { if (__any((a) < 1.f)) { if (hi == 0) al_l[r32] = (a); asm volatile("s_waitcnt lgkmcnt(0)" ::: "memory");              \
                     for (int d_ = 0; d_ < 4; ++d_) for (int r = 0; r < 16; ++r) o[d_][r] *= al_l[crow(r, hi)]; } } while (0)
#define KBASE(t) ((t) * KVBLK)
#define MASKT(P0_, P1_, t) do { const int kb_ = KBASE(t); if (kb_ + KVBLK - 1 > qlo) mask_tile(P0_, P1_, qm - kb_); } while (0)
#define SEAM_K0() do { VMWN(8); SWRITE_HK(0); SBAR(); } while (0)
    f32x16 pA0, pA1, pB0, pB1; float mnA, mnB, alA, alB; bf16x8 pa0, pa1, pa2, pa3;
    SWRITE_HV(0); SBAR();
    if (NT > 1) SLOAD_H(Kh, Vh, KBASE(1));
    SBAR(); qkt<0>(pA0, pA1, K_lds, r32, hi, S.qr, bl + KBASE(0));
    MASKT(pA0, pA1, 0); partialSM(pA0, pA1, m_reg, mnA, alA);
    if (NT > 1) { VMW(); SWRITE_H(1); }
    __syncthreads();
#define HALF_STEP(PX0, PX1, mnX, alX, PY0, PY1, alY, t, KB, VB, SB) do {                                                      \
        SBAR(); qkt<KB>(PX0, PX1, K_lds, r32, hi, S.qr, bl + KBASE(t));                                                       \
        finishSM(PY0, PY1, alY, l_reg, pa0, pa1, pa2, pa3); SBAR();                                                           \
        if ((t) + 1 < NT) { SLOAD_H(Kh, Vh, KBASE((t) + 1)); SBAR(); }                                                        \
        pv_tile<VB>(o, vb0, pa0, pa1, pa2, pa3); MASKT(PX0, PX1, (t)); partialSM(PX0, PX1, m_reg, mnX, alX);                  \
        __syncthreads();                                                                                                      \
        if ((t) + 1 < NT) { VMW(); SWRITE_H(SB); }                                                                            \
        RESC(alX); __syncthreads(); } while (0)
    for (int t = 1; t + 1 < NT; t += 2) {
        HALF_STEP(pB0, pB1, mnB, alB, pA0, pA1, alA, t, 1, 0, 0);
        HALF_STEP(pA0, pA1, mnA, alA, pB0, pB1, alB, t + 1, 0, 1, 1);
    }
    SBAR(); qkt<1>(pB0, pB1, K_lds, r32, hi, S.qr, bl + KBASE(NT - 1)); SBAR();
    SLOAD_H(nxt.K, nxt.V, 0); SBAR();
#pragma unroll
    for (int d0 = 0; d0 < 8; ++d0) S.qr[d0] = ld8((const bf16*)((const char*)nxt.Q + (unsigned)((wid * QBLK + r32) * LDP + hi * 8) * 2u + d0 * 32));
    SBAR();
    finishSM(pA0, pA1, alA, l_reg, pa0, pa1, pa2, pa3); SBAR();
    pv_tile<0>(o, vb0, pa0, pa1, pa2, pa3);
    MASKT(pB0, pB1, NT - 1); partialSM(pB0, pB1, m_reg, mnB, alB); __syncthreads(); RESC(alB);
    finishSM(pB0, pB1, alB, l_reg, pa0, pa1, pa2, pa3); SBAR(); pv_tile<1>(o, vb0, pa0, pa1, pa2, pa3);
    SBAR(); SEAM_K0();
    if (hi == 0) li_l[r32] = l_reg; asm volatile("s_waitcnt lgkmcnt(0)" ::: "memory");
    float rli[16];
#pragma unroll
    for (int r = 0; r < 16; ++r) rli[r] = __builtin_amdgcn_rcpf(li_l[crow(r, hi)]);
    bf16* Ow = cur.O + (size_t)(wid * QBLK) * KM;
#pragma unroll
    for (int r = 0; r < 16; ++r) { const int orow = crow(r, hi);
#pragma unroll
        for (int d0 = 0; d0 < 4; ++d0) { const float v = o[d0][r] * rli[r];
            const float vn = __shfl_xor(v, 1);
            if ((r32 & 1) == 0) *(unsigned*)(Ow + (size_t)orow * KM + d0 * 32 + r32) = cvt_pk_bf16(v, vn); } }
    __syncthreads();
#undef RESC
#undef KBASE
#undef MASKT
#undef SEAM_K0
#undef HALF_STEP
}
#undef ROWB
#undef VMW
#undef VMWN
#undef SLOAD_H
#undef SWRITE_HK
#undef SWRITE_HV
#undef SWRITE_H
struct Item { int bh, qb0, qb1; };
__device__ __forceinline__ Item decode(int L) { Item it; it.bh = L >> 3; const int x = L & 7; it.qb0 = x; it.qb1 = 15 - x; return it; }
__device__ __forceinline__ BlockRef ref(const Item& it, int pass, const bf16* PROJ, bf16* AM) {
    const int qb = pass ? it.qb1 : it.qb0, b = it.bh / FOX_H, h = it.bh % FOX_H; BlockRef r;
    const size_t row0 = (size_t)b * SEQ;
    r.Q = PROJ + (row0 + (size_t)qb * QB) * LDP + PQ + h * D; r.K = PROJ + row0 * LDP + PK + h * D; r.V = PROJ + row0 * LDP + PV + h * D;
    r.O = AM + (row0 + (size_t)qb * QB) * KM + D_INNER + h * D; r.P0 = qb * QB; return r;
}
__device__ __forceinline__ void build_bias(lptr lds, const float* LCh) {
    const LAS float* pref = (const LAS float*)(lds + OFF_PREF); LAS float* bl = (LAS float*)(lds + OFF_BL);
    int s0 = threadIdx.x * 8; asm volatile("" : "+v"(s0));
    const float fref = LCh[SEQ / 2 - 1] + pref[(SEQ / 2 - 1) >> 6]; const float pc = pref[s0 >> 6];
    const f32x4 a = *(const f32x4*)(LCh + s0), b = *(const f32x4*)(LCh + s0 + 4);
    constexpr float IS = 1.f / SCALE;
    *(LAS f32x4*)(bl + s0) = (fref - (a + pc)) * IS; *(LAS f32x4*)(bl + s0 + 4) = (fref - (b + pc)) * IS;
}
__device__ __forceinline__ void build_pref(lptr lds, const float* CTh) {
    int lane = threadIdx.x; asm volatile("" : "+v"(lane));
    if (lane < 64) { const float v = CTh[lane]; float inc = v;
#pragma unroll
        for (int o = 1; o < 64; o <<= 1) { const float u = __shfl_up(inc, o); if (lane >= o) inc += u; }
        ((LAS float*)(lds + OFF_PREF))[lane] = inc - v; }
}
__device__ __forceinline__ void phase(lptr lds, const bf16* PROJ, const float* LC, const float* CT, bf16* AM, int G, int bx) {
    const int total = 8 * BATCH * FOX_H, stride = G;
    int L = (G % 8 == 0) ? (bx % 8) * (G / 8) + bx / 8 : bx;
    if (L >= total) return;
    Item it = decode(L); int pass = 0;
    BlockRef cur = ref(it, 0, PROJ, AM);
    Seam S;
    build_pref(lds, CT + it.bh * 64); __syncthreads();
    build_bias(lds, LC + (size_t)it.bh * SEQ);
    prime(cur, lds, S);
    for (;;) {
        const bool more_pass = pass == 0, more_item = L + stride < total, last = !more_pass && !more_item;
        Item itn = it; int passn = pass + 1, Ln = L;
        if (!more_pass) { passn = 0; Ln = more_item ? L + stride : L; itn = decode(Ln); }
        const BlockRef nxt = last ? cur : ref(itn, passn, PROJ, AM);
        block(cur, nxt, lds, S);
        if (last) break;
        if (itn.bh != it.bh) { build_pref(lds, CT + itn.bh * 64); __syncthreads(); build_bias(lds, LC + (size_t)itn.bh * SEQ); __syncthreads(); }
        cur = nxt; it = itn; pass = passn; L = Ln;
    }
}
#undef KSWZ
#undef SBAR
}

enum { PH_PROLOGUE = 0, PH_INPROJ, PH_PREP, PH_SSD, PH_ATTN, PH_NORM, PH_MERGE1, PH_MERGE2, PH_MIX, PH_LN1, PH_UP, PH_ACT, PH_DOWN, PH_LN2, PH_COUNT };

__global__ void __launch_bounds__(NWAVES * 64, 2) mk_fwd(Params p) {
    extern __shared__ __attribute__((aligned(16))) unsigned char lds_raw[];
    Frame F;
    F.lds = (LAS unsigned char*)lds_raw;
    volatile LAS unsigned* MISC = (volatile LAS unsigned*)(F.lds + MISC_OFF);
    F.tid = threadIdx.x; F.lane = F.tid & 63; F.wave = __builtin_amdgcn_readfirstlane(F.tid >> 6);
    F.G = gridDim.x; F.gw = blockIdx.x * NWAVES + F.wave; F.ngw = F.G * NWAVES;
    F.x = p.in[0]; F.w_in = p.in[1]; F.conv_w = p.in[2]; F.conv_b = p.in[3]; F.dt_bias = p.in[4]; F.a_log = p.in[5]; F.ssd_d = p.in[6]; F.norm_w = p.in[7]; F.f_bias = p.in[8]; F.gate_bias = p.in[9];
    F.w_pssd = p.in[10]; F.w_patt = p.in[11]; F.w_out = p.in[12]; F.ln1_g = p.in[13]; F.ln1_b = p.in[14]; F.w_up = p.in[15]; F.fconv_w = p.in[16]; F.fconv_b = p.in[17]; F.w_down = p.in[18]; F.ln2_g = p.in[19]; F.ln2_b = p.in[20];
    F.out = p.out;
    unsigned char* ws = p.ws;
    F.XB = (bf16*)(ws + WS_XB); F.WIN = (bf16*)(ws + WS_WIN); F.WP = (bf16*)(ws + WS_WP); F.WO = (bf16*)(ws + WS_WO); F.WUP = (bf16*)(ws + WS_WUP); F.WD = (bf16*)(ws + WS_WD);
    F.PROJ = (bf16*)(ws + WS_PROJ); F.XACT = (bf16*)(ws + WS_XACT); F.AM = (bf16*)(ws + WS_AM); F.MG = (bf16*)(ws + WS_MG); F.H1B = (bf16*)(ws + WS_H1B); F.U = (bf16*)(ws + WS_U); F.ACT = (bf16*)(ws + WS_ACT);
    F.DTF = (float*)(ws + WS_DTF); F.DTV = (float*)(ws + WS_DTV); F.LC = (float*)(ws + WS_LC); F.CT = (float*)(ws + WS_CT); F.SSQ = (float*)(ws + WS_SSQ); F.M1 = (float*)(ws + WS_M1); F.H1 = (float*)(ws + WS_H1);
    for (int u = F.tid; u < (LDS_BYTES - RING_BYTES) / 4; u += NWAVES * 64) ((LAS unsigned*)(F.lds + RING_BYTES))[u] = 0u;
    __syncthreads();
    const int lo = p.ph_lo, hi = p.ph_hi;
    XcdBarrier bar; bar.bar = (unsigned*)(ws + WS_CTL) + CW_BAR; bar.x = 0; bar.st = nullptr;
    if (hi - lo > 1) bar = xcd_barrier_post((unsigned*)(ws + WS_CTL) + CW_BAR, MISC + 8);
#define IN(k) (lo <= (k) && (k) < hi)
#define SEAM(k) do { if (IN(k) && IN((k) + 1)) xcd_barrier(bar); } while (0)

    if (IN(PH_PROLOGUE)) { {  p0_prologue(F);  } if (PROBE_MASK >> PH_PROLOGUE & 1) { VM_WAIT(); __syncthreads(); {  p0_prologue(F);  } } } SEAM(PH_PROLOGUE);

    if (IN(PH_INPROJ)) { {
        { pg8::Gemm g{F.XB, F.WIN, D_MODEL, D_MODEL, D_MODEL}; pg8::StaticOrder S; S.init(T, LDP, F.G, (int)blockIdx.x); pg8::EpiStoreBf16 E{F.PROJ, LDP};
          pg8::gemm_phase<pg8::EpiStoreBf16, pg8::StaticOrder, true>(F.lds, g, S, E); }
        { pg8::Gemm g{F.XB, F.WIN + (size_t)PSMALL * D_MODEL, D_MODEL, D_MODEL, KSLAB}; pg8::SplitKOrder S{T / 256, NSLAB, KSLAB, F.G, (int)blockIdx.x}; pg8::EpiSlabF32 E{F.DTF, KSLAB, (size_t)T * 256};
          pg8::gemm_phase<pg8::EpiSlabF32, pg8::SplitKOrder, false>(F.lds, g, S, E); }
     } if (PROBE_MASK >> PH_INPROJ & 1) { VM_WAIT(); __syncthreads(); {
        { pg8::Gemm g{F.XB, F.WIN, D_MODEL, D_MODEL, D_MODEL}; pg8::StaticOrder S; S.init(T, LDP, F.G, (int)blockIdx.x); pg8::EpiStoreBf16 E{F.PROJ, LDP};
          pg8::gemm_phase<pg8::EpiStoreBf16, pg8::StaticOrder, true>(F.lds, g, S, E); }
        { pg8::Gemm g{F.XB, F.WIN + (size_t)PSMALL * D_MODEL, D_MODEL, D_MODEL, KSLAB}; pg8::SplitKOrder S{T / 256, NSLAB, KSLAB, F.G, (int)blockIdx.x}; pg8::EpiSlabF32 E{F.DTF, KSLAB, (size_t)T * 256};
          pg8::gemm_phase<pg8::EpiSlabF32, pg8::SplitKOrder, false>(F.lds, g, S, E); }
     } } } SEAM(PH_INPROJ);

    if (IN(PH_PREP)) { {  p2_prep(F);  } if (PROBE_MASK >> PH_PREP & 1) { VM_WAIT(); __syncthreads(); {  p2_prep(F);  } } } SEAM(PH_PREP);

    if (IN(PH_SSD)) { {  ssd::phase((ssd::lptr)F.lds, F.PROJ, F.XACT, F.DTV, F.a_log, F.ssd_d, F.AM, F.SSQ, F.G, (int)blockIdx.x);  } if (PROBE_MASK >> PH_SSD & 1) { VM_WAIT(); __syncthreads(); {  ssd::phase((ssd::lptr)F.lds, F.PROJ, F.XACT, F.DTV, F.a_log, F.ssd_d, F.AM, F.SSQ, F.G, (int)blockIdx.x);  } } } SEAM(PH_SSD);
    if (IN(PH_ATTN)) { {  fox::phase((fox::lptr)F.lds, F.PROJ, F.LC, F.CT, F.AM, F.G, (int)blockIdx.x);  } if (PROBE_MASK >> PH_ATTN & 1) { VM_WAIT(); __syncthreads(); {  fox::phase((fox::lptr)F.lds, F.PROJ, F.LC, F.CT, F.AM, F.G, (int)blockIdx.x);  } } } SEAM(PH_ATTN);

    if (IN(PH_NORM)) { {  p5_norm(F);  } if (PROBE_MASK >> PH_NORM & 1) { VM_WAIT(); __syncthreads(); {  p5_norm(F);  } } } SEAM(PH_NORM);

    if (IN(PH_MERGE1)) { {  pg8::Gemm g{F.AM, F.WP, KM, KM, D_INNER}; pg8::StaticOrder S; S.init(T, D_MODEL, F.G, (int)blockIdx.x); pg8::EpiGate1 E{F.PROJ, F.gate_bias, F.M1};
        pg8::gemm_phase<pg8::EpiGate1, pg8::StaticOrder, true>(F.lds, g, S, E);  } if (PROBE_MASK >> PH_MERGE1 & 1) { VM_WAIT(); __syncthreads(); {  pg8::Gemm g{F.AM, F.WP, KM, KM, D_INNER}; pg8::StaticOrder S; S.init(T, D_MODEL, F.G, (int)blockIdx.x); pg8::EpiGate1 E{F.PROJ, F.gate_bias, F.M1};
        pg8::gemm_phase<pg8::EpiGate1, pg8::StaticOrder, true>(F.lds, g, S, E);  } } } SEAM(PH_MERGE1);

    if (IN(PH_MERGE2)) { {  pg8::Gemm g{F.AM + D_INNER, F.WP + D_INNER, KM, KM, D_ATT}; pg8::StaticOrder S; S.init(T, D_MODEL, F.G, (int)blockIdx.x); pg8::EpiGate2 E{F.PROJ, F.gate_bias + D_MODEL, F.M1, F.MG};
        pg8::gemm_phase<pg8::EpiGate2, pg8::StaticOrder, true>(F.lds, g, S, E);  } if (PROBE_MASK >> PH_MERGE2 & 1) { VM_WAIT(); __syncthreads(); {  pg8::Gemm g{F.AM + D_INNER, F.WP + D_INNER, KM, KM, D_ATT}; pg8::StaticOrder S; S.init(T, D_MODEL, F.G, (int)blockIdx.x); pg8::EpiGate2 E{F.PROJ, F.gate_bias + D_MODEL, F.M1, F.MG};
        pg8::gemm_phase<pg8::EpiGate2, pg8::StaticOrder, true>(F.lds, g, S, E);  } } } SEAM(PH_MERGE2);

    if (IN(PH_MIX)) { {  pg8::Gemm g{F.MG, F.WO, D_MODEL, D_MODEL, D_MODEL}; pg8::StaticOrder S; S.init(T, D_MODEL, F.G, (int)blockIdx.x); pg8::EpiResid E{F.x, F.M1};
        pg8::gemm_phase<pg8::EpiResid, pg8::StaticOrder, true>(F.lds, g, S, E);  } if (PROBE_MASK >> PH_MIX & 1) { VM_WAIT(); __syncthreads(); {  pg8::Gemm g{F.MG, F.WO, D_MODEL, D_MODEL, D_MODEL}; pg8::StaticOrder S; S.init(T, D_MODEL, F.G, (int)blockIdx.x); pg8::EpiResid E{F.x, F.M1};
        pg8::gemm_phase<pg8::EpiResid, pg8::StaticOrder, true>(F.lds, g, S, E);  } } } SEAM(PH_MIX);

    if (IN(PH_LN1)) { {  ln_rows<true>(F, F.M1, F.ln1_g, F.ln1_b, F.H1, F.H1B);  } if (PROBE_MASK >> PH_LN1 & 1) { VM_WAIT(); __syncthreads(); {  ln_rows<true>(F, F.M1, F.ln1_g, F.ln1_b, F.H1, F.H1B);  } } } SEAM(PH_LN1);

    if (IN(PH_UP)) { {  pg8::Gemm g{F.H1B, F.WUP, D_MODEL, D_MODEL, D_MODEL}; pg8::StaticOrder S; S.init(T, 2 * D_FF, F.G, (int)blockIdx.x); pg8::EpiStoreBf16 E{F.U, 2 * D_FF};
        pg8::gemm_phase<pg8::EpiStoreBf16, pg8::StaticOrder, true>(F.lds, g, S, E);  } if (PROBE_MASK >> PH_UP & 1) { VM_WAIT(); __syncthreads(); {  pg8::Gemm g{F.H1B, F.WUP, D_MODEL, D_MODEL, D_MODEL}; pg8::StaticOrder S; S.init(T, 2 * D_FF, F.G, (int)blockIdx.x); pg8::EpiStoreBf16 E{F.U, 2 * D_FF};
        pg8::gemm_phase<pg8::EpiStoreBf16, pg8::StaticOrder, true>(F.lds, g, S, E);  } } } SEAM(PH_UP);

    if (IN(PH_ACT)) { {  constexpr int N_ACT = (T / 16) * 43; for (int it = F.gw; it < N_ACT; it += F.ngw) p11_act_item(F, it);  } if (PROBE_MASK >> PH_ACT & 1) { VM_WAIT(); __syncthreads(); {  constexpr int N_ACT = (T / 16) * 43; for (int it = F.gw; it < N_ACT; it += F.ngw) p11_act_item(F, it);  } } } SEAM(PH_ACT);

    if (IN(PH_DOWN)) { {  pg8::Gemm g{F.ACT, F.WD, D_FF, D_FF, D_FF}; pg8::StaticOrder S; S.init(T, D_MODEL, F.G, (int)blockIdx.x); pg8::EpiResid E{F.H1, F.M1};
        pg8::gemm_phase<pg8::EpiResid, pg8::StaticOrder, true>(F.lds, g, S, E);  } if (PROBE_MASK >> PH_DOWN & 1) { VM_WAIT(); __syncthreads(); {  pg8::Gemm g{F.ACT, F.WD, D_FF, D_FF, D_FF}; pg8::StaticOrder S; S.init(T, D_MODEL, F.G, (int)blockIdx.x); pg8::EpiResid E{F.H1, F.M1};
        pg8::gemm_phase<pg8::EpiResid, pg8::StaticOrder, true>(F.lds, g, S, E);  } } } SEAM(PH_DOWN);

    if (IN(PH_LN2)) { {  ln_rows<false>(F, F.M1, F.ln2_g, F.ln2_b, F.out, nullptr);  } if (PROBE_MASK >> PH_LN2 & 1) { VM_WAIT(); __syncthreads(); {  ln_rows<false>(F, F.M1, F.ln2_g, F.ln2_b, F.out, nullptr);  } } }
#undef IN
#undef SEAM
}

extern "C" void kernel_launch(void* const* d_in, const int* in_sizes, int n_in, void* d_out, int out_size, void* d_ws, size_t ws_size, hipStream_t stream) {
    static int grid = 0;
    if (grid == 0) {
        if (n_in != 21 || in_sizes[0] != T * D_MODEL || out_size != T * D_MODEL || ws_size < WS_END) { fprintf(stderr, "kernel_launch: unexpected shapes (n_in %d, in0 %d, out %d, ws %zu < %zu); nothing launched\n", n_in, n_in > 0 ? in_sizes[0] : -1, out_size, ws_size, (size_t)WS_END); grid = -1; return; }
        int dev = 0, cus = 0, per_cu = 0;
        if (hipGetDevice(&dev) != hipSuccess || hipDeviceGetAttribute(&cus, hipDeviceAttributeMultiprocessorCount, dev) != hipSuccess) { grid = -1; return; }
        if (hipFuncSetAttribute((const void*)mk_fwd, hipFuncAttributeMaxDynamicSharedMemorySize, LDS_BYTES) != hipSuccess) { fprintf(stderr, "kernel_launch: hipFuncSetAttribute failed\n"); grid = -1; return; }
        if (hipOccupancyMaxActiveBlocksPerMultiprocessor(&per_cu, (const void*)mk_fwd, NWAVES * 64, LDS_BYTES) != hipSuccess || per_cu < 1) fprintf(stderr, "kernel_launch: note: occupancy query reports %d workgroups per CU\n", per_cu);
        (void)hipGetLastError();
        grid = cus;
    }
    if (grid < 0) return;
    (void)hipMemsetAsync((char*)d_ws + WS_CTL, 0, CTL_ZERO_BYTES, stream);
    Params p{};
    for (int i = 0; i < 21; ++i) p.in[i] = (const float*)d_in[i];
    p.out = (float*)d_out; p.ws = (unsigned char*)d_ws;
#if MK_ONE_LAUNCH
    p.ph_lo = 0; p.ph_hi = PH_COUNT;
    hipLaunchKernelGGL(mk_fwd, dim3(grid), dim3(NWAVES * 64), LDS_BYTES, stream, p);
#else
    for (int ph = 0; ph < PH_COUNT; ++ph) {
        p.ph_lo = ph; p.ph_hi = ph + 1;
        hipLaunchKernelGGL(mk_fwd, dim3(grid), dim3(NWAVES * 64), LDS_BYTES, stream, p);
    }
#endif
}
```

```cpp
#include <hip/hip_runtime.h>
#include <cstdio>
#include <cstdint>

#ifndef PROBE_MASK
#define PROBE_MASK 0
#endif
#ifndef MK_ONE_LAUNCH
#define MK_ONE_LAUNCH 1
#endif

namespace cfg {
constexpr int D_MODEL = 4096, BATCH = 2, SEQ = 4096, T = BATCH * SEQ;
constexpr int D_INNER = 8192, SSD_P = 64, SSD_H = 128, SSD_N = 128, SSD_G = 8, SSD_R = 16, CONV_DIM = 10240;
constexpr int FOX_HD = 128, FOX_H = 32, D_ATT = 4096, D_FF = 11008;
constexpr int OFF_DT = 18432, OFF_Q = 18560, OFF_F = 30848, OFF_GS = 30880, NPROJ = 39072;
constexpr int PZ = 0, PXBC = 8192, PQ = 18432, PK = 22528, PV = 26624, PGS = 30720, PGA = 34816, LDP = 38912, PSMALL = 38912, NWIN = 39168;
constexpr int KM = 12288;
constexpr int NSLAB = 8, KSLAB = 512;
constexpr float ALPHA = 1.189207115002721f;
constexpr float LN_EPS = 1e-5f, RMS_EPS = 1e-5f;
constexpr size_t MiB = 1u << 20;
constexpr size_t WS_CTL = 0, CTL_ZERO_BYTES = 1 * MiB;
constexpr size_t WS_XB = 1 * MiB, WS_WIN = 65 * MiB, WS_WP = 371 * MiB, WS_WO = 467 * MiB, WS_WUP = 499 * MiB, WS_WD = 671 * MiB;
constexpr size_t WS_PROJ = 757 * MiB, WS_DTF = 1365 * MiB, WS_XACT = 1429 * MiB, WS_DTV = 1589 * MiB, WS_LC = 1593 * MiB, WS_CT = 1594 * MiB, WS_SSQ = 1595 * MiB;
constexpr size_t WS_AM = 1603 * MiB, WS_M1 = 1795 * MiB, WS_MG = 1923 * MiB, WS_H1 = 1987 * MiB, WS_H1B = 2115 * MiB, WS_END = 2179 * MiB;
constexpr size_t WS_U = WS_PROJ, WS_ACT = WS_PROJ + 344 * MiB;
static_assert(WS_WIN + (size_t)NWIN * D_MODEL * 2 == WS_WP && WS_WP + (size_t)D_MODEL * KM * 2 == WS_WO && WS_WUP + (size_t)2 * D_FF * D_MODEL * 2 == WS_WD && WS_WD + (size_t)D_MODEL * D_FF * 2 == WS_PROJ, "ws map (weights)");
static_assert(WS_PROJ + (size_t)T * LDP * 2 == WS_DTF && WS_DTF + (size_t)NSLAB * T * 256 * 4 == WS_XACT && WS_XACT + (size_t)T * CONV_DIM * 2 == WS_DTV && WS_AM + (size_t)T * KM * 2 == WS_M1, "ws map (activations)");
static_assert(WS_ACT + (size_t)T * D_FF * 2 <= WS_DTF && WS_U + (size_t)T * 2 * D_FF * 2 == WS_ACT, "u/act overlay proj");
constexpr int CW_BAR = 4096;
}
using namespace cfg;

#define LAS __attribute__((address_space(3)))
#define GAS __attribute__((address_space(1)))
typedef unsigned short bf16;
typedef short bf16x8 __attribute__((ext_vector_type(8)));
typedef float f32x4 __attribute__((ext_vector_type(4)));
typedef float f32x2 __attribute__((ext_vector_type(2)));
typedef unsigned u32x4 __attribute__((ext_vector_type(4)));
typedef unsigned u32x2 __attribute__((ext_vector_type(2)));
#define LDS_WAIT() asm volatile("s_waitcnt lgkmcnt(0)" ::: "memory")
#define VM_WAIT() asm volatile("s_waitcnt vmcnt(0)" ::: "memory")

__device__ __forceinline__ unsigned cvt_pk_bf16(float lo, float hi) { unsigned r; asm volatile("v_cvt_pk_bf16_f32 %0, %1, %2" : "=v"(r) : "v"(lo), "v"(hi)); return r; }
__device__ __forceinline__ float bf_lo(unsigned w) { return __uint_as_float(w << 16); }
__device__ __forceinline__ float bf_hi(unsigned w) { return __uint_as_float(w & 0xffff0000u); }
__device__ __forceinline__ float bf2f(bf16 b) { return __uint_as_float(((unsigned)b) << 16); }
__device__ __forceinline__ float silu_f(float x) { return x * __builtin_amdgcn_rcpf(1.f + __expf(-x)); }
__device__ __forceinline__ float sigmoid_f(float x) { return __builtin_amdgcn_rcpf(1.f + __expf(-x)); }
__device__ __forceinline__ float softplus_f(float x) { return x > 20.f ? x : log1pf(__expf(x)); }
__device__ __forceinline__ float logsigmoid_f(float x) { return fminf(x, 0.f) - log1pf(__expf(-fabsf(x))); }
__device__ __forceinline__ void unpack8(const u32x4 w, float (&v)[8]) { v[0] = bf_lo(w.x); v[1] = bf_hi(w.x); v[2] = bf_lo(w.y); v[3] = bf_hi(w.y); v[4] = bf_lo(w.z); v[5] = bf_hi(w.z); v[6] = bf_lo(w.w); v[7] = bf_hi(w.w); }

namespace pg8 {
constexpr int BM = 256, BK = 64, HALF = 128, HTB = HALF * BK * 2, STAGE_BYTES = 8 * HTB, NXCD = 8, WGM = 8;
__host__ __device__ __forceinline__ int lds_byte(int r, int c) { const int st = (r >> 4) * 2 + (c >> 5), rr = r & 15, cc = c & 31, ob = rr * 64 + cc * 2; return st * 1024 + (ob ^ (((ob >> 9) & 1) << 5)); }
__host__ __device__ __forceinline__ void stage_rc(int b, int& R, int& C) { const int st = b / 1024, sb = b % 1024, swz = sb ^ (((sb >> 9) & 1) << 5); R = (st >> 1) * 16 + swz / 64; C = (st & 1) * 32 + (swz % 64) / 2; }
__host__ __device__ __forceinline__ int perm32(int rho) { const int n = rho >> 4, i = rho & 15; return 8 * (i >> 2) + 4 * n + (i & 3); }

struct Unit { int pm, pn, ka, nkt; };
struct Gemm { const bf16* A; const bf16* Bt; int lda, ldb, K; };

struct StaticOrder {
    int nM, nN, nwg, G, c, nkt;
    __host__ __device__ void init(int M, int N, int G_, int c_, int K_) { nM = M / BM; nN = N / BM; nwg = nM * nN; G = G_; c = c_; nkt = K_ / BK; }
    __host__ __device__ bool next(int i, Unit& u) const {
        const long L = (long)i * G + c; if (L >= nwg) return false;
        int wgid = (int)L; { const int q = nwg / NXCD, r = nwg % NXCD, xcd = wgid % NXCD, off = wgid / NXCD; wgid = (xcd < r ? xcd * (q + 1) : r * (q + 1) + (xcd - r) * q) + off; }
        const int nig = WGM * nN, gid = wgid / nig, fm = gid * WGM, gsz = (nM - fm) < WGM ? (nM - fm) : WGM;
        u.pm = fm + ((wgid % nig) % gsz); u.pn = (wgid % nig) / gsz; u.ka = 0; u.nkt = nkt; return true;
    }
    __device__ __forceinline__ void a_ready(const Unit&) const {}
    __device__ __forceinline__ void done(const Unit&) const {}
};
struct MergeOrder : StaticOrder {
    __host__ __device__ bool next(int i, Unit& u) const { const bool ok = StaticOrder::next(i >> 1, u); if (i & 1) { u.ka = D_INNER; u.nkt = D_ATT / BK; } else { u.ka = 0; u.nkt = D_INNER / BK; } return ok; }
};
struct SplitKOrder {
    int nM, nS, kslab, G, c;
    __host__ __device__ bool next(int i, Unit& u) const { const long L = (long)i * G + c; if (L >= (long)nM * nS) return false; u.pm = (int)(L % nM); u.pn = 0; u.ka = (int)(L / nM) * kslab; u.nkt = kslab / BK; return true; }
    __device__ __forceinline__ void a_ready(const Unit&) const {}
    __device__ __forceinline__ void done(const Unit&) const {}
};

struct EpiStoreBf16 {
    static constexpr bool PERM = true;
    bf16* O; int ldc;
    __device__ __forceinline__ void operator()(const f32x4 (&acc)[2][2][4][2], const Unit& u, int wr, int wc, int fr, int fq) const {
        const int row0 = u.pm * BM + wr * 64 + fr, col0 = u.pn * BM + wc * 32 + 8 * fq;
#pragma unroll
        for (int ai = 0; ai < 2; ++ai)
#pragma unroll
            for (int m = 0; m < 4; ++m) { bf16* rowp = O + (size_t)(row0 + ai * HALF + m * 16) * ldc + col0;
#pragma unroll
                for (int bj = 0; bj < 2; ++bj) { const f32x4 v0 = acc[ai][bj][m][0], v1 = acc[ai][bj][m][1];
                    u32x4 w; w.x = cvt_pk_bf16(v0[0], v0[1]); w.y = cvt_pk_bf16(v0[2], v0[3]); w.z = cvt_pk_bf16(v1[0], v1[1]); w.w = cvt_pk_bf16(v1[2], v1[3]);
                    *(u32x4*)(rowp + bj * HALF) = w; } }
    }
};
struct EpiSlabF32 {
    static constexpr bool PERM = false;
    float* C; int kslab; size_t slab_stride;
    __device__ __forceinline__ void operator()(const f32x4 (&acc)[2][2][4][2], const Unit& u, int wr, int wc, int fr, int fq) const {
        float* base = C + (size_t)(u.ka / kslab) * slab_stride;
        const int row0 = u.pm * BM + wr * 64 + fr, col0 = wc * 32 + 4 * fq;
#pragma unroll
        for (int ai = 0; ai < 2; ++ai)
#pragma unroll
            for (int m = 0; m < 4; ++m) { float* rowp = base + (size_t)(row0 + ai * HALF + m * 16) * 256 + col0;
#pragma unroll
                for (int bj = 0; bj < 2; ++bj)
#pragma unroll
                    for (int n = 0; n < 2; ++n) *(f32x4*)(rowp + bj * HALF + n * 16) = acc[ai][bj][m][n]; }
    }
};
struct MergeHook {
    static constexpr bool ON = true; static constexpr int SEG = 16;
    LAS float* tab; const float* RT; const bf16* proj; const float* gb;
    __device__ __forceinline__ void unit_start(const Unit& u) const {
        int tid = threadIdx.x; asm volatile("" : "+v"(tid)); const int row = tid >> 1, half = tid & 1;
        const f32x4 v = *(const f32x4*)(RT + (size_t)(u.pm * BM + row) * 8 + half * 4);
        *(LAS f32x4*)(tab + row * 8 + half * 4) = v;
    }
    __device__ __forceinline__ void after(int te, f32x4 (&acc)[2][2][4][2], const Unit& u, int wr, int wc, int fr, int fq) const {
        if (te > D_INNER / BK) return;
        const int g = (te >> 4) - 1;
        asm volatile("" : "+v"(fr), "+v"(fq));
#pragma unroll
        for (int ai = 0; ai < 2; ++ai)
#pragma unroll
            for (int m = 0; m < 4; ++m) { const float f = tab[(ai * HALF + wr * 64 + m * 16 + fr) * 8 + g];
#pragma unroll
                for (int bj = 0; bj < 2; ++bj)
#pragma unroll
                    for (int n = 0; n < 2; ++n) acc[ai][bj][m][n] *= f; }
        if (g == 7) {
            const int row0 = u.pm * BM + wr * 64 + fr, col0 = u.pn * BM + wc * 32 + 8 * fq;
#pragma unroll
            for (int bj = 0; bj < 2; ++bj) { const int c = col0 + bj * HALF;
                const f32x4 s0 = *(const f32x4*)(gb + c), s1 = *(const f32x4*)(gb + c + 4), a0 = *(const f32x4*)(gb + D_MODEL + c), a1 = *(const f32x4*)(gb + D_MODEL + c + 4);
#pragma unroll
                for (int ai = 0; ai < 2; ++ai) {
                    u32x4 gs[4], ga[4];
#pragma unroll
                    for (int m = 0; m < 4; ++m) { const size_t r = (size_t)(row0 + ai * HALF + m * 16); gs[m] = *(const u32x4*)(proj + r * LDP + PGS + c); ga[m] = *(const u32x4*)(proj + r * LDP + PGA + c); }
#pragma unroll
                    for (int m = 0; m < 4; ++m) { float vs[8], va[8]; unpack8(gs[m], vs); unpack8(ga[m], va);
#pragma unroll
                        for (int e = 0; e < 4; ++e) {
                            acc[ai][bj][m][0][e] *= (1.f + __expf(-(va[e] + a0[e]))) * __builtin_amdgcn_rcpf(1.f + __expf(-(vs[e] + s0[e])));
                            acc[ai][bj][m][1][e] *= (1.f + __expf(-(va[4 + e] + a1[e]))) * __builtin_amdgcn_rcpf(1.f + __expf(-(vs[4 + e] + s1[e]))); } }
                    asm volatile("" ::: "memory");
                } }
        }
    }
};
struct EpiMerge {
    static constexpr bool PERM = true;
    const bf16* proj; const float* gb; bf16* MG;
    __device__ __forceinline__ void operator()(const f32x4 (&acc)[2][2][4][2], const Unit& u, int wr, int wc, int fr, int fq) const {
        int row0 = u.pm * BM + wr * 64 + fr, col0 = u.pn * BM + wc * 32 + 8 * fq;
        asm volatile("" : "+v"(row0), "+v"(col0));
#pragma unroll
        for (int bj = 0; bj < 2; ++bj) { const int c = col0 + bj * HALF; const f32x4 b0 = *(const f32x4*)(gb + c), b1 = *(const f32x4*)(gb + c + 4);
#pragma unroll
            for (int ai = 0; ai < 2; ++ai)
#pragma unroll
                for (int m = 0; m < 4; ++m) { const size_t r = (size_t)(row0 + ai * HALF + m * 16);
                    const u32x4 ga = *(const u32x4*)(proj + r * LDP + PGA + c); float va[8]; unpack8(ga, va);
                    const f32x4 v0 = acc[ai][bj][m][0], v1 = acc[ai][bj][m][1];
                    u32x4 w; w.x = cvt_pk_bf16(v0[0] * sigmoid_f(va[0] + b0[0]), v0[1] * sigmoid_f(va[1] + b0[1])); w.y = cvt_pk_bf16(v0[2] * sigmoid_f(va[2] + b0[2]), v0[3] * sigmoid_f(va[3] + b0[3]));
                    w.z = cvt_pk_bf16(v1[0] * sigmoid_f(va[4] + b1[0]), v1[1] * sigmoid_f(va[5] + b1[1])); w.w = cvt_pk_bf16(v1[2] * sigmoid_f(va[6] + b1[2]), v1[3] * sigmoid_f(va[7] + b1[3]));
                    *(u32x4*)(MG + r * D_MODEL + c) = w; } }
    }
};
struct EpiResid {
    static constexpr bool PERM = false;
    const float* base; float* out;
    __device__ __forceinline__ void operator()(const f32x4 (&acc)[2][2][4][2], const Unit& u, int wr, int wc, int fr, int fq) const {
        int row0 = u.pm * BM + wr * 64 + fr, col0 = u.pn * BM + wc * 32 + 4 * fq;
        asm volatile("" : "+v"(row0), "+v"(col0));
#pragma unroll
        for (int ai = 0; ai < 2; ++ai)
#pragma unroll
            for (int m = 0; m < 4; ++m) { const size_t off = (size_t)(row0 + ai * HALF + m * 16) * D_MODEL + col0;
#pragma unroll
                for (int bj = 0; bj < 2; ++bj)
#pragma unroll
                    for (int n = 0; n < 2; ++n) { const f32x4 bs = *(const f32x4*)(base + off + bj * HALF + n * 16); *(f32x4*)(out + off + bj * HALF + n * 16) = bs * ALPHA + acc[ai][bj][m][n]; } }
    }
};

struct NoHook { static constexpr bool ON = false; static constexpr int SEG = 0;
    __device__ __forceinline__ void unit_start(const Unit&) const {}
    __device__ __forceinline__ void after(int, f32x4 (&)[2][2][4][2], const Unit&, int, int, int, int) const {} };
template <class Epi, class Sched, bool ALIGN_EPI, class Hook = NoHook>
__device__ __forceinline__ void gemm_phase(LAS unsigned char* lds, const Gemm g, const Sched& S, const Epi& E, const Hook& H = Hook()) {
    const int tid = threadIdx.x, wid = __builtin_amdgcn_readfirstlane(tid >> 6), lane = tid & 63, wr = wid >> 2, wc = wid & 3, fr = lane & 15, fq = lane >> 4;
    unsigned voffA[2], voffB[2];
#pragma unroll
    for (int i = 0; i < 2; ++i) { int R, C; stage_rc(tid * 16 + i * 8192, R, C); const int Rb = Epi::PERM ? ((R & ~31) + perm32(R & 31)) : R;
        voffA[i] = (unsigned)(R * g.lda + C) * 2u; voffB[i] = (unsigned)(Rb * g.ldb + C) * 2u; }
    const size_t kstep = (size_t)(BK * 2);
    const size_t hA = (size_t)HALF * g.lda * 2, hB = (size_t)HALF * g.ldb * 2;
    const unsigned ldsw = (unsigned)wid * 1024u;
    const int aoff = lds_byte(wr * 64 + fr, fq * 8), boff = lds_byte(wc * 32 + fr, fq * 8);
#define PG8_SA(b, h) (((b) * 2 + (h)) * HTB)
#define PG8_SB(b, h) ((4 + (b) * 2 + (h)) * HTB)
#define PG8_STAGE(bufoff, gbase, voff) do { _Pragma("unroll") for (int _i = 0; _i < 2; ++_i) \
        __builtin_amdgcn_global_load_lds((const unsigned*)((const char*)(gbase) + (voff)[_i]), (LAS unsigned*)(lds + (bufoff) + ldsw + _i * 8192), 16, 0, 0); } while (0)
#define PG8_LDA(dst, b, h) do { _Pragma("unroll") for (int m = 0; m < 4; ++m) _Pragma("unroll") for (int k = 0; k < 2; ++k) dst[m][k] = *(const LAS bf16x8*)(lds + PG8_SA(b, h) + aoff + m * 2048 + k * 1024); } while (0)
#define PG8_LDB(dst, b, h) do { _Pragma("unroll") for (int n = 0; n < 2; ++n) _Pragma("unroll") for (int k = 0; k < 2; ++k) dst[n][k] = *(const LAS bf16x8*)(lds + PG8_SB(b, h) + boff + n * 2048 + k * 1024); } while (0)
#define PG8_MMA(ai, bj, At, Bt) do { __builtin_amdgcn_s_setprio(1); _Pragma("unroll") for (int m = 0; m < 4; ++m) _Pragma("unroll") for (int n = 0; n < 2; ++n) _Pragma("unroll") for (int k = 0; k < 2; ++k) \
        acc[ai][bj][m][n] = __builtin_amdgcn_mfma_f32_16x16x32_bf16(Bt[n][k], At[m][k], acc[ai][bj][m][n], 0, 0, 0); __builtin_amdgcn_s_setprio(0); } while (0)
#define PG8_WAIT_V(n) asm volatile("s_waitcnt vmcnt(" #n ")" ::: "memory")
#define PG8_WAIT_L(n) asm volatile("s_waitcnt lgkmcnt(" #n ")" ::: "memory")
#define PG8_BAR __builtin_amdgcn_s_barrier()
#define PG8_SCHED __builtin_amdgcn_sched_barrier(0)
    Unit cur, nxt; int ui = 0;
    if (!S.next(0, cur)) return;
    f32x4 acc[2][2][4][2];
#pragma unroll
    for (int a = 0; a < 2; ++a)
#pragma unroll
        for (int b = 0; b < 2; ++b)
#pragma unroll
            for (int m = 0; m < 4; ++m)
#pragma unroll
                for (int n = 0; n < 2; ++n) acc[a][b][m][n] = (f32x4){0.f, 0.f, 0.f, 0.f};
    bf16x8 At[4][2], B0[2][2], B1[2][2];
    const char* cA = (const char*)g.A + (size_t)cur.pm * 2 * hA + (size_t)cur.ka * 2; const char* cB = (const char*)g.Bt + (size_t)cur.pn * 2 * hB + (size_t)cur.ka * 2;
    S.a_ready(cur);
    if constexpr (Hook::ON) H.unit_start(cur);
    PG8_STAGE(PG8_SB(0, 0), cB, voffB); PG8_STAGE(PG8_SB(0, 1), cB + hB, voffB); PG8_STAGE(PG8_SA(0, 0), cA, voffA); PG8_STAGE(PG8_SA(0, 1), cA + hA, voffA);
    if (wr == 1) PG8_BAR;
    PG8_WAIT_V(2); PG8_BAR;
    PG8_STAGE(PG8_SB(1, 0), cB + kstep, voffB); PG8_STAGE(PG8_SA(1, 0), cA + kstep, voffA); PG8_STAGE(PG8_SB(1, 1), cB + hB + kstep, voffB);
    PG8_WAIT_V(6); PG8_BAR;
    for (;;) {
        const bool has_next = S.next(ui + 1, nxt);
        const char* nA = has_next ? (const char*)g.A + (size_t)nxt.pm * 2 * hA + (size_t)nxt.ka * 2 : cA; const char* nB = has_next ? (const char*)g.Bt + (size_t)nxt.pn * 2 * hB + (size_t)nxt.ka * 2 : cB;
        const int nt = cur.nkt;
        for (int tb = 0; tb < nt; tb += (Hook::ON ? Hook::SEG : nt)) {
        const int te = Hook::ON ? tb + Hook::SEG : nt;
        for (int t = tb; t < te; t += 2) {
            const bool last = (t == nt - 2);
            const char* a1 = cA + (size_t)(t + 1) * kstep;
            const char* a2 = last ? nA : cA + (size_t)(t + 2) * kstep; const char* b2 = last ? nB : cB + (size_t)(t + 2) * kstep;
            const char* a3 = a2 + kstep; const char* b3 = b2 + kstep;
            if (last && has_next) S.a_ready(nxt);
            PG8_LDB(B0, 0, 0); PG8_LDB(B1, 0, 1); PG8_SCHED; PG8_LDA(At, 0, 0); PG8_STAGE(PG8_SA(1, 1), a1 + hA, voffA);
            PG8_WAIT_V(8); PG8_WAIT_L(0); PG8_BAR; PG8_MMA(0, 0, At, B0); PG8_MMA(0, 1, At, B1); PG8_BAR; PG8_SCHED;
            PG8_LDA(At, 0, 1); PG8_STAGE(PG8_SB(0, 0), b2, voffB); PG8_STAGE(PG8_SB(0, 1), b2 + hB, voffB); PG8_STAGE(PG8_SA(0, 0), a2, voffA);
            PG8_WAIT_V(8); PG8_WAIT_L(0); PG8_BAR; PG8_MMA(1, 0, At, B0); PG8_MMA(1, 1, At, B1); PG8_BAR; PG8_SCHED;
            PG8_LDB(B0, 1, 0); PG8_LDB(B1, 1, 1); PG8_SCHED; PG8_LDA(At, 1, 0); PG8_STAGE(PG8_SA(0, 1), a2 + hA, voffA);
            PG8_WAIT_V(8); PG8_WAIT_L(0); PG8_BAR; PG8_MMA(0, 0, At, B0); PG8_MMA(0, 1, At, B1); PG8_BAR; PG8_SCHED;
            PG8_LDA(At, 1, 1); PG8_STAGE(PG8_SB(1, 0), b3, voffB); PG8_STAGE(PG8_SB(1, 1), b3 + hB, voffB); PG8_STAGE(PG8_SA(1, 0), a3, voffA);
            PG8_WAIT_V(8); PG8_WAIT_L(0); PG8_BAR; PG8_MMA(1, 0, At, B0); PG8_MMA(1, 1, At, B1); PG8_BAR; PG8_SCHED;
        }
        if constexpr (Hook::ON) H.after(te, acc, cur, wr, wc, fr, fq);
        }
        if constexpr (ALIGN_EPI) { if (wr == 0) PG8_BAR; }
        E(acc, cur, wr, wc, fr, fq); S.done(cur);
        if (!has_next) break;
        if constexpr (Hook::ON) H.unit_start(nxt);
#pragma unroll
        for (int a = 0; a < 2; ++a)
#pragma unroll
            for (int b = 0; b < 2; ++b)
#pragma unroll
                for (int m = 0; m < 4; ++m)
#pragma unroll
                    for (int n = 0; n < 2; ++n) acc[a][b][m][n] = (f32x4){0.f, 0.f, 0.f, 0.f};
        cur = nxt; cA = nA; cB = nB; ++ui;
        if constexpr (ALIGN_EPI) { if (wr == 1) PG8_BAR; }
    }
    PG8_WAIT_V(0);
    if constexpr (!ALIGN_EPI) { if (wr == 0) PG8_BAR; }
    PG8_BAR;
#undef PG8_SA
#undef PG8_SB
#undef PG8_STAGE
#undef PG8_LDA
#undef PG8_LDB
#undef PG8_MMA
#undef PG8_WAIT_V
#undef PG8_WAIT_L
#undef PG8_BAR
#undef PG8_SCHED
}
}

#define XB_TMO      128
#define XB_XCNT(j)  (256  + 64 * (j))
#define XB_XSUB(j)  (1280 + 64 * (j))
#define XB_XGEN(j)  (2304 + 64 * (j))
#define XB_TOP      3328
#define XB_TOPGEN   3392
#define XCD_BAR_WORDS 3456
#define XB_SPIN_CAP (1u << 20)
__device__ __forceinline__ unsigned xb_ld(unsigned* p)              { return __hip_atomic_load(p, __ATOMIC_RELAXED, __HIP_MEMORY_SCOPE_AGENT); }
__device__ __forceinline__ unsigned xb_add(unsigned* p, unsigned v) { return __hip_atomic_fetch_add(p, v, __ATOMIC_RELAXED, __HIP_MEMORY_SCOPE_AGENT); }
__device__ __forceinline__ unsigned xb_xcc_id() { return (unsigned)__builtin_amdgcn_s_getreg((3 << 11) | 20) & 0xFu; }
#define XB_SPIN(cond, bar) do { unsigned _sp = 0; while (cond) { __builtin_amdgcn_s_sleep(1); \
    if ((++_sp & 255u) == 0u) { if (xb_ld(&(bar)[XB_TMO])) break; if (_sp > XB_SPIN_CAP) { atomicAdd(&(bar)[XB_TMO], 1u); break; } } } } while (0)
struct XcdBarrier { unsigned* bar; unsigned x; volatile LAS unsigned* st; };
__device__ __forceinline__ XcdBarrier xcd_barrier_post(unsigned* bar, volatile LAS unsigned* st) {
    XcdBarrier b; b.bar = bar; b.x = xb_xcc_id(); b.st = st;
    if (threadIdx.x == 0) (void)xb_add(&bar[XB_XCNT(b.x)], 1u);
    return b;
}
__device__ __forceinline__ void xcd_barrier_complete(unsigned* bar, unsigned x, unsigned& nloc, unsigned& nx) {
    const unsigned G = gridDim.x * gridDim.y * gridDim.z;
    unsigned sum, cnt, mine, sp = 0u;
    for (;;) {
        sum = 0u; cnt = 0u; mine = 0u;
#pragma unroll
        for (unsigned j = 0; j < 16; ++j) { const unsigned c = xb_ld(&bar[XB_XCNT(j)]); sum += c; cnt += (c > 0u) ? 1u : 0u; mine = (j == x) ? c : mine; }
        if (sum == G) break;
        __builtin_amdgcn_s_sleep(1);
        if ((++sp & 255u) == 0u) { if (xb_ld(&bar[XB_TMO])) break; if (sp > XB_SPIN_CAP) { atomicAdd(&bar[XB_TMO], 1u); break; } }
    }
    nloc = mine > 0u ? mine : 1u; nx = cnt > 0u ? cnt : 1u;
}
__device__ __forceinline__ void xcd_barrier(const XcdBarrier& b) {
    asm volatile("s_waitcnt vmcnt(0)" ::: "memory");
    __syncthreads();
    if (threadIdx.x == 0) {
        unsigned* bar = b.bar;
        __builtin_amdgcn_s_waitcnt(0);
        unsigned nloc = b.st[0], nx = b.st[1];
        if (nloc == 0u) { xcd_barrier_complete(bar, b.x, nloc, nx); b.st[0] = nloc; b.st[1] = nx; }
        const unsigned old = xb_add(&bar[XB_XSUB(b.x)], 1u);
        const unsigned gen = old / nloc;
        if (old + 1u == (gen + 1u) * nloc) {
            __builtin_amdgcn_fence(__ATOMIC_RELEASE, "agent");
            asm volatile("s_waitcnt vmcnt(0)" ::: "memory");
            const unsigned og = xb_add(&bar[XB_TOP], 1u);
            const unsigned tg = og / nx;
            if (og + 1u == (tg + 1u) * nx) xb_add(&bar[XB_TOPGEN], 1u);
            else XB_SPIN(xb_ld(&bar[XB_TOPGEN]) == tg, bar);
            __builtin_amdgcn_fence(__ATOMIC_ACQUIRE, "agent");
            xb_add(&bar[XB_XGEN(b.x)], 1u);
            asm volatile("s_waitcnt vmcnt(0)" ::: "memory");
        } else {
            XB_SPIN(xb_ld(&bar[XB_XGEN(b.x)]) == gen, bar);
            __builtin_amdgcn_fence(__ATOMIC_ACQUIRE, "agent");
            asm volatile("s_waitcnt vmcnt(0)" ::: "memory");
        }
    }
    __syncthreads();
}

constexpr int NWAVES = 8;
constexpr int RING_BYTES = 131072, MISC_OFF = RING_BYTES + 320, LDS_BYTES = 147456;
struct Params {
    const float* in[21]; float* out; unsigned char* ws; int ph_lo, ph_hi;
};
struct Frame {
    LAS unsigned char* lds; int tid, lane, wave, G, gw, ngw;
    const float *x, *w_in, *conv_w, *conv_b, *dt_bias, *a_log, *ssd_d, *norm_w, *f_bias, *gate_bias, *w_pssd, *w_patt, *w_out, *ln1_g, *ln1_b, *w_up, *fconv_w, *fconv_b, *w_down, *ln2_g, *ln2_b;
    float* out;
    bf16 *XB, *WIN, *WP, *WO, *WUP, *WD, *PROJ, *XACT, *AM, *MG, *H1B, *U, *ACT;
    float *DTF, *DTV, *LC, *CT, *SSQ, *RT, *M1, *H1;
};

__device__ __forceinline__ void transpose_item(const float* __restrict__ W, int N, int k0, int n0, bf16* dst, int ldt, const float* kscale, LAS float* scr, int lane) {
    float v[32];
#pragma unroll
    for (int i = 0; i < 32; ++i) { const int kk = 2 * i + (lane >> 5); v[i] = __builtin_nontemporal_load(W + (size_t)(k0 + kk) * N + n0 + (lane & 31)); }
    if (kscale) {
#pragma unroll
        for (int i = 0; i < 32; ++i) { const int kk = 2 * i + (lane >> 5); v[i] *= kscale[k0 + kk]; } }
#pragma unroll
    for (int i = 0; i < 32; ++i) { const int kk = 2 * i + (lane >> 5); scr[kk * 33 + (lane & 31)] = v[i]; }
    LDS_WAIT();
    const int c = lane & 7;
#pragma unroll
    for (int j = 0; j < 4; ++j) { const int n = (lane >> 3) + 8 * j; const LAS float* s = scr + (8 * c) * 33 + n;
        u32x4 o; o.x = cvt_pk_bf16(s[0 * 33], s[1 * 33]); o.y = cvt_pk_bf16(s[2 * 33], s[3 * 33]); o.z = cvt_pk_bf16(s[4 * 33], s[5 * 33]); o.w = cvt_pk_bf16(s[6 * 33], s[7 * 33]);
        *(u32x4*)(dst + (size_t)n * ldt + 8 * c) = o; }
    LDS_WAIT();
}
__device__ __forceinline__ int win_row(int n) {
    return n < OFF_DT ? n : (n < OFF_Q ? PSMALL + (n - OFF_DT) : (n < OFF_F ? n - 128 : (n < OFF_GS ? PSMALL + 128 + (n - OFF_F) : n - 160)));
}
__device__ __forceinline__ void p0_prologue(Frame& F) {
    LAS float* scr = (LAS float*)(F.lds + F.wave * 16384);
    constexpr int I_IN = (D_MODEL / 64) * (NPROJ / 32), I_PS = (D_INNER / 64) * (D_MODEL / 32), I_PA = (D_ATT / 64) * (D_MODEL / 32), I_O = (D_MODEL / 64) * (D_MODEL / 32);
    constexpr int I_UP = (D_MODEL / 64) * (2 * D_FF / 32), I_DN = (D_FF / 64) * (D_MODEL / 32);
    constexpr int NITEMS = I_IN + I_PS + I_PA + I_O + I_UP + I_DN;
    for (int it = F.gw; it < NITEMS; it += F.ngw) {
        int r = it;
        if (r < I_IN) { const int nb = NPROJ / 32, kb = r / nb, n0 = (r % nb) * 32; transpose_item(F.w_in, NPROJ, kb * 64, n0, F.WIN + (size_t)win_row(n0) * D_MODEL + kb * 64, D_MODEL, nullptr, scr, F.lane); continue; } r -= I_IN;
        if (r < I_PS) { const int nb = D_MODEL / 32, kb = r / nb, n0 = (r % nb) * 32; transpose_item(F.w_pssd, D_MODEL, kb * 64, n0, F.WP + (size_t)n0 * KM + kb * 64, KM, F.norm_w, scr, F.lane); continue; } r -= I_PS;
        if (r < I_PA) { const int nb = D_MODEL / 32, kb = r / nb, n0 = (r % nb) * 32; transpose_item(F.w_patt, D_MODEL, kb * 64, n0, F.WP + (size_t)n0 * KM + D_INNER + kb * 64, KM, nullptr, scr, F.lane); continue; } r -= I_PA;
        if (r < I_O) { const int nb = D_MODEL / 32, kb = r / nb, n0 = (r % nb) * 32; transpose_item(F.w_out, D_MODEL, kb * 64, n0, F.WO + (size_t)n0 * D_MODEL + kb * 64, D_MODEL, nullptr, scr, F.lane); continue; } r -= I_O;
        if (r < I_UP) { const int nb = 2 * D_FF / 32, kb = r / nb, n0 = (r % nb) * 32; transpose_item(F.w_up, 2 * D_FF, kb * 64, n0, F.WUP + (size_t)n0 * D_MODEL + kb * 64, D_MODEL, nullptr, scr, F.lane); continue; } r -= I_UP;
        { const int nb = D_MODEL / 32, kb = r / nb, n0 = (r % nb) * 32; transpose_item(F.w_down, D_MODEL, kb * 64, n0, F.WD + (size_t)n0 * D_FF + kb * 64, D_FF, nullptr, scr, F.lane); }
    }
    const size_t gt = (size_t)F.gw * 64 + F.lane, nth = (size_t)F.ngw * 64;
    for (size_t i = gt; i < (size_t)T * D_MODEL / 8; i += nth) { const f32x4 a = *(const f32x4*)(F.x + i * 8), b = *(const f32x4*)(F.x + i * 8 + 4);
        u32x4 w; w.x = cvt_pk_bf16(a[0], a[1]); w.y = cvt_pk_bf16(a[2], a[3]); w.z = cvt_pk_bf16(b[0], b[1]); w.w = cvt_pk_bf16(b[2], b[3]); *(u32x4*)(F.XB + i * 8) = w; }
}

__device__ __forceinline__ void p2_conv_item(Frame& F, int item) {
    const int tb = item / 20, cb = item % 20, t0 = tb * 16, c0 = cb * 512 + F.lane * 8;
    const bool first = (t0 & (SEQ - 1)) == 0;
    const bf16* src = F.PROJ + (size_t)t0 * LDP + PXBC + c0;
    u32x4 rw[19];
#pragma unroll
    for (int i = 0; i < 3; ++i) rw[i] = first ? (u32x4){0u, 0u, 0u, 0u} : *(const u32x4*)(src - (3 - i) * (size_t)LDP);
#pragma unroll
    for (int i = 0; i < 16; ++i) rw[3 + i] = *(const u32x4*)(src + (size_t)i * LDP);
    float w[4][8], bs[8];
#pragma unroll
    for (int k = 0; k < 4; ++k) { const f32x4 a = *(const f32x4*)(F.conv_w + k * CONV_DIM + c0), b = *(const f32x4*)(F.conv_w + k * CONV_DIM + c0 + 4);
#pragma unroll
        for (int j = 0; j < 4; ++j) { w[k][j] = a[j]; w[k][4 + j] = b[j]; } }
    { const f32x4 a = *(const f32x4*)(F.conv_b + c0), b = *(const f32x4*)(F.conv_b + c0 + 4);
#pragma unroll
      for (int j = 0; j < 4; ++j) { bs[j] = a[j]; bs[4 + j] = b[j]; } }
    float x0[8], x1[8], x2[8], x3[8];
    unpack8(rw[0], x0); unpack8(rw[1], x1); unpack8(rw[2], x2);
#pragma unroll
    for (int i = 0; i < 16; ++i) {
        unpack8(rw[3 + i], x3);
        float o[8];
#pragma unroll
        for (int j = 0; j < 8; ++j) { float a = bs[j]; a = fmaf(w[0][j], x0[j], a); a = fmaf(w[1][j], x1[j], a); a = fmaf(w[2][j], x2[j], a); a = fmaf(w[3][j], x3[j], a); o[j] = silu_f(a); x0[j] = x1[j]; x1[j] = x2[j]; x2[j] = x3[j]; }
        u32x4 q; q.x = cvt_pk_bf16(o[0], o[1]); q.y = cvt_pk_bf16(o[2], o[3]); q.z = cvt_pk_bf16(o[4], o[5]); q.w = cvt_pk_bf16(o[6], o[7]);
        *(u32x4*)(F.XACT + (size_t)(t0 + i) * CONV_DIM + c0) = q;
    }
}
__device__ __forceinline__ void p2_dt_item(Frame& F, int item) {
#pragma unroll
    for (int j = 0; j < 8; ++j) { const int e = item * 512 + j * 64 + F.lane, t = e >> 7, h = e & 127; float s = 0.f;
#pragma unroll
        for (int ks = 0; ks < NSLAB; ++ks) s += F.DTF[((size_t)ks * T + t) * 256 + h];
        F.DTV[(size_t)t * SSD_H + h] = softplus_f(s + F.dt_bias[h]); }
}
__device__ __forceinline__ void p2_fcum_item(Frame& F, int item) {
    const int b = item >> 6, c = item & 63, t = b * SEQ + c * 64 + F.lane;
#pragma unroll 1
    for (int h4 = 0; h4 < FOX_H; h4 += 4) {
        f32x4 s = (f32x4){0.f, 0.f, 0.f, 0.f};
#pragma unroll
        for (int ks = 0; ks < NSLAB; ++ks) s += *(const f32x4*)(F.DTF + ((size_t)ks * T + t) * 256 + 128 + h4);
#pragma unroll
        for (int j = 0; j < 4; ++j) { float v = logsigmoid_f(s[j] + F.f_bias[h4 + j]);
#pragma unroll
            for (int o = 1; o < 64; o <<= 1) { const float u = __shfl_up(v, o); if (F.lane >= o) v += u; }
            F.LC[(size_t)(b * FOX_H + h4 + j) * SEQ + c * 64 + F.lane] = v;
            if (F.lane == 63) F.CT[(b * FOX_H + h4 + j) * 64 + c] = v; }
    }
}
__device__ __forceinline__ void p2_prep(Frame& F) {
    constexpr int N_FC = BATCH * 64, N_CONV = (T / 16) * 20, N_DT = T * SSD_H / 512;
    for (int it = F.gw; it < N_FC + N_CONV + N_DT; it += F.ngw) {
        if (it < N_FC) p2_fcum_item(F, it); else if (it < N_FC + N_CONV) p2_conv_item(F, it - N_FC); else p2_dt_item(F, it - N_FC - N_CONV);
    }
}

__device__ __forceinline__ void rt_rows(Frame& F) {
    for (int t = F.gw; t < T; t += F.ngw) {
        const f32x4 q = *(const f32x4*)(F.SSQ + (size_t)t * 256 + F.lane * 4);
        float s0 = (q[0] + q[1]) + (q[2] + q[3]);
#pragma unroll
        for (int o = 1; o < 8; o <<= 1) s0 += __shfl_xor(s0, o);
        const float r = rsqrtf(s0 * (1.f / 1024.f) + RMS_EPS);
        const float rn = __shfl(r, (F.lane + 8) & 63);
        if ((F.lane & 7) == 0) F.RT[(size_t)t * 8 + (F.lane >> 3)] = (F.lane < 56) ? r / rn : r;
    }
}

__device__ __forceinline__ float wave_sum(float v) {
#pragma unroll
    for (int o = 1; o < 64; o <<= 1) v += __shfl_xor(v, o);
    return v;
}
template <bool WITH_BF16> __device__ __forceinline__ void ln_rows(Frame& F, const float* src, const float* g, const float* b, float* dst, bf16* dstb) {
    f32x4 nx[16];
    if (F.gw < T) { const f32x4* xr = (const f32x4*)(src + (size_t)F.gw * D_MODEL) + F.lane;
#pragma unroll
        for (int j = 0; j < 16; ++j) nx[j] = xr[64 * j]; }
    for (int t = F.gw; t < T; t += F.ngw) {
        f32x4 v[16]; float s = 0.f;
#pragma unroll
        for (int j = 0; j < 16; ++j) { v[j] = nx[j]; s += (v[j][0] + v[j][1]) + (v[j][2] + v[j][3]); }
        if (t + F.ngw < T) { const f32x4* xr = (const f32x4*)(src + (size_t)(t + F.ngw) * D_MODEL) + F.lane;
#pragma unroll
            for (int j = 0; j < 16; ++j) nx[j] = xr[64 * j]; }
        const float mean = wave_sum(s) * (1.f / D_MODEL); float q = 0.f;
#pragma unroll
        for (int j = 0; j < 16; ++j) { v[j] = v[j] - mean; q += (v[j][0] * v[j][0] + v[j][1] * v[j][1]) + (v[j][2] * v[j][2] + v[j][3] * v[j][3]); }
        const float rstd = rsqrtf(wave_sum(q) * (1.f / D_MODEL) + LN_EPS);
#pragma unroll
        for (int j = 0; j < 16; ++j) { const int c = (64 * j + F.lane) * 4; const f32x4 gg = *(const f32x4*)(g + c), bb = *(const f32x4*)(b + c); const f32x4 o = v[j] * rstd * gg + bb;
            *(f32x4*)(dst + (size_t)t * D_MODEL + c) = o;
            if (WITH_BF16) { u32x2 w; w.x = cvt_pk_bf16(o[0], o[1]); w.y = cvt_pk_bf16(o[2], o[3]); *(u32x2*)(dstb + (size_t)t * D_MODEL + c) = w; } }
    }
}

__device__ __forceinline__ void p11_act_item(Frame& F, int item) {
    const int tb = item / 43, cb = item % 43, t0 = tb * 16, c0 = cb * 256 + F.lane * 4;
    const bool first = (t0 & (SEQ - 1)) == 0;
    const bf16* src = F.U + (size_t)t0 * (2 * D_FF) + c0;
    u32x2 rv[18], rg[18];
#pragma unroll
    for (int i = 0; i < 2; ++i) { rv[i] = first ? (u32x2){0u, 0u} : *(const u32x2*)(src - (2 - i) * (size_t)(2 * D_FF)); rg[i] = first ? (u32x2){0u, 0u} : *(const u32x2*)(src - (2 - i) * (size_t)(2 * D_FF) + D_FF); }
#pragma unroll
    for (int i = 0; i < 16; ++i) { rv[2 + i] = *(const u32x2*)(src + (size_t)i * (2 * D_FF)); rg[2 + i] = *(const u32x2*)(src + (size_t)i * (2 * D_FF) + D_FF); }
    f32x4 wv[3], wg[3];
#pragma unroll
    for (int k = 0; k < 3; ++k) { wv[k] = *(const f32x4*)(F.fconv_w + k * 2 * D_FF + c0); wg[k] = *(const f32x4*)(F.fconv_w + k * 2 * D_FF + D_FF + c0); }
    const f32x4 bv = *(const f32x4*)(F.fconv_b + c0), bg = *(const f32x4*)(F.fconv_b + D_FF + c0);
    auto up4 = [](const u32x2 w) { return (f32x4){bf_lo(w.x), bf_hi(w.x), bf_lo(w.y), bf_hi(w.y)}; };
    f32x4 v0 = up4(rv[0]), v1 = up4(rv[1]), g0 = up4(rg[0]), g1 = up4(rg[1]);
#pragma unroll
    for (int i = 0; i < 16; ++i) {
        const f32x4 v2 = up4(rv[2 + i]), g2 = up4(rg[2 + i]);
        const f32x4 cv = bv + wv[0] * v0 + wv[1] * v1 + wv[2] * v2, cg = bg + wg[0] * g0 + wg[1] * g1 + wg[2] * g2;
        u32x2 w; w.x = cvt_pk_bf16(silu_f(cg[0]) * cv[0], silu_f(cg[1]) * cv[1]); w.y = cvt_pk_bf16(silu_f(cg[2]) * cv[2], silu_f(cg[3]) * cv[3]);
        *(u32x2*)(F.ACT + (size_t)(t0 + i) * D_FF + c0) = w;
        v0 = v1; v1 = v2; g0 = g1; g1 = g2;
    }
}

namespace ssd {
typedef float f32x16 __attribute__((ext_vector_type(16)));
typedef LAS char* lptr;
constexpr int PCM = 272, PBM = 272, PBT = 144, PXT = 144, PHB = 272;
constexpr int O_CM = 0, O_BM = O_CM + 64 * PCM, O_BT = O_BM + 64 * PBM, O_XT = O_BT + 128 * PBT, O_HB = O_XT + 64 * PXT, O_VEC = O_HB + 64 * PHB, SSD_LDS = O_VEC + 1024;
constexpr int V_DT = 0, V_ACS = 256, V_W = 512, V_E = 768;
__device__ __forceinline__ int crow(int r, int hi) { return (r & 3) + 8 * (r >> 2) + 4 * hi; }
__device__ __forceinline__ void tr_block_write(const u32x4 (&blk)[8], lptr base, int pitch, int cg, int tg) {
#pragma unroll
    for (int j = 0; j < 8; ++j) {
        u32x4 o;
#pragma unroll
        for (int m = 0; m < 4; ++m) { const unsigned a = blk[2 * m][j >> 1], b = blk[2 * m + 1][j >> 1];
            o[m] = (j & 1) ? ((a >> 16) | (b & 0xffff0000u)) : ((a & 0xffffu) | (b << 16)); }
        *(LAS u32x4*)(base + (cg * 8 + j) * pitch + tg * 16) = o;
    }
}
struct Pre { u32x4 nat[4]; u32x4 blk[8]; float dtr; };
__device__ __forceinline__ void loads(Pre& P, const bf16* XACT, const float* DTV, size_t t0, int h, int g, int tid, int wid, int lane) {
    const int rowA = tid >> 4, ch = tid & 15;
    const bf16* cm = XACT + (t0 + rowA) * CONV_DIM + D_INNER + SSD_G * SSD_N + g * SSD_N + ch * 8;
    const bf16* bm = XACT + (t0 + rowA) * CONV_DIM + D_INNER + g * SSD_N + ch * 8;
    P.nat[0] = *(const u32x4*)cm; P.nat[1] = *(const u32x4*)(cm + 32 * (size_t)CONV_DIM); P.nat[2] = *(const u32x4*)bm; P.nat[3] = *(const u32x4*)(bm + 32 * (size_t)CONV_DIM);
    if (wid == 4) { const int cg = lane >> 3, tg = lane & 7; const bf16* p = XACT + (t0 + tg * 8) * CONV_DIM + h * SSD_P + cg * 8;
#pragma unroll
        for (int i = 0; i < 8; ++i) P.blk[i] = *(const u32x4*)(p + (size_t)i * CONV_DIM); }
    else if (wid == 5 || wid == 6) { const int idx = (wid - 5) * 64 + lane, cg = idx >> 3, tg = idx & 7; const bf16* p = XACT + (t0 + tg * 8) * CONV_DIM + D_INNER + g * SSD_N + cg * 8;
#pragma unroll
        for (int i = 0; i < 8; ++i) P.blk[i] = *(const u32x4*)(p + (size_t)i * CONV_DIM); }
    else if (wid == 7) P.dtr = DTV[(t0 + lane) * SSD_H + h];
}
__device__ __forceinline__ bf16x8 pack8f(const float (&v)[8]) { u32x4 w = {cvt_pk_bf16(v[0], v[1]), cvt_pk_bf16(v[2], v[3]), cvt_pk_bf16(v[4], v[5]), cvt_pk_bf16(v[6], v[7])}; return *reinterpret_cast<bf16x8*>(&w); }
__device__ __forceinline__ void phase(lptr lds, const bf16* PROJ, const bf16* XACT, const float* DTV, const float* a_log, const float* dskip, bf16* AM, float* SSQ, int G, int bx) {
    const int tid = threadIdx.x, wid = __builtin_amdgcn_readfirstlane(tid >> 6), lane = tid & 63, r32 = lane & 31, hi = lane >> 5;
    const LAS float* vec = (const LAS float*)(lds + O_VEC);
    for (int bh = bx; bh < BATCH * SSD_H; bh += G) {
        const int b = bh / SSD_H, h = bh % SSD_H, g = h / SSD_R;
        const float a = -__expf(a_log[h]), dsk = dskip[h];
        const size_t row0 = (size_t)b * SEQ;
        f32x16 st = {};
        Pre P;
        loads(P, XACT, DTV, row0, h, g, tid, wid, lane);
        u32x2 zn[4];
        if (wid < 4) { const bf16* zp = PROJ + (row0 + 32 * (wid & 1) + r32) * LDP + PZ + h * SSD_P + 32 * (wid >> 1) + 4 * hi;
#pragma unroll
            for (int q = 0; q < 4; ++q) zn[q] = *(const u32x2*)(zp + 8 * q); }
        for (int c = 0; c < SEQ / 64; ++c) {
            const size_t t0 = row0 + (size_t)c * 64;
            { const int rowA = tid >> 4, ch = tid & 15;
              *(LAS u32x4*)(lds + O_CM + rowA * PCM + ch * 16) = P.nat[0]; *(LAS u32x4*)(lds + O_CM + (rowA + 32) * PCM + ch * 16) = P.nat[1];
              *(LAS u32x4*)(lds + O_BM + rowA * PBM + ch * 16) = P.nat[2]; *(LAS u32x4*)(lds + O_BM + (rowA + 32) * PBM + ch * 16) = P.nat[3]; }
            if (wid == 4) tr_block_write(P.blk, lds + O_XT, PXT, lane >> 3, lane & 7);
            else if (wid == 5 || wid == 6) { const int idx = (wid - 5) * 64 + lane; tr_block_write(P.blk, lds + O_BT, PBT, idx >> 3, idx & 7); }
            else if (wid == 7) { const float dtv = P.dtr; float acs = dtv * a;
#pragma unroll
                for (int o = 1; o < 64; o <<= 1) { const float u = __shfl_up(acs, o); if (lane >= o) acs += u; }
                const float a63 = __shfl(acs, 63);
                LAS float* vw = (LAS float*)(lds + O_VEC);
                vw[V_DT / 4 + lane] = dtv; vw[V_ACS / 4 + lane] = acs; vw[V_W / 4 + lane] = __expf(a63 - acs) * dtv; vw[V_E / 4 + lane] = __expf(acs); }
            { const int nt = wid & 3, pt = wid >> 2; lptr hb = lds + O_HB + (32 * pt + r32) * PHB + (32 * nt + 4 * hi) * 2;
#pragma unroll
              for (int q = 0; q < 4; ++q) { u32x2 w; w.x = cvt_pk_bf16(st[4 * q], st[4 * q + 1]); w.y = cvt_pk_bf16(st[4 * q + 2], st[4 * q + 3]); *(LAS u32x2*)(hb + 16 * q) = w; } }
            LDS_WAIT(); __syncthreads();
            if (c + 1 < SEQ / 64) loads(P, XACT, DTV, t0 + 64, h, g, tid, wid, lane);
            if (wid < 4) {
                const int lt = wid & 1, pt2 = wid >> 1;
                u32x2 zr[4];
#pragma unroll
                for (int q = 0; q < 4; ++q) zr[q] = zn[q];
                if (c + 1 < SEQ / 64) { const bf16* zp = PROJ + (t0 + 64 + 32 * lt + r32) * LDP + PZ + h * SSD_P + 32 * pt2 + 4 * hi;
#pragma unroll
                    for (int q = 0; q < 4; ++q) zn[q] = *(const u32x2*)(zp + 8 * q); }
                const float acsl = vec[V_ACS / 4 + 32 * lt + r32];
                bf16x8 gf[2][2];
                const lptr cmrow = lds + O_CM + (32 * lt + r32) * PCM + hi * 16;
#pragma unroll
                for (int s_ = 0; s_ < 2; ++s_) if (s_ <= lt) {
                    f32x16 cb = {};
                    const lptr bmrow = lds + O_BM + (32 * s_ + r32) * PBM + hi * 16;
#pragma unroll
                    for (int kk = 0; kk < 8; ++kk) cb = __builtin_amdgcn_mfma_f32_32x32x16_bf16(*(const LAS bf16x8*)(bmrow + kk * 32), *(const LAS bf16x8*)(cmrow + kk * 32), cb, 0, 0, 0);
                    float gv[16];
#pragma unroll
                    for (int q = 0; q < 4; ++q) { const f32x4 as4 = *(const LAS f32x4*)(vec + V_ACS / 4 + 32 * s_ + 8 * q + 4 * hi), dt4 = *(const LAS f32x4*)(vec + V_DT / 4 + 32 * s_ + 8 * q + 4 * hi);
#pragma unroll
                        for (int e = 0; e < 4; ++e) { const int srow = 32 * s_ + 8 * q + 4 * hi + e; gv[4 * q + e] = (srow <= 32 * lt + r32) ? cb[4 * q + e] * __expf(acsl - as4[e]) * dt4[e] : 0.f; } }
                    { float t8[8];
#pragma unroll
                      for (int e = 0; e < 8; ++e) t8[e] = gv[e];
                      gf[s_][0] = pack8f(t8);
#pragma unroll
                      for (int e = 0; e < 8; ++e) t8[e] = gv[8 + e];
                      gf[s_][1] = pack8f(t8); }
                }
                f32x16 y = {};
                { const lptr hbrow = lds + O_HB + (32 * pt2 + r32) * PHB + hi * 16;
#pragma unroll
                  for (int kk = 0; kk < 8; ++kk) y = __builtin_amdgcn_mfma_f32_32x32x16_bf16(*(const LAS bf16x8*)(hbrow + kk * 32), *(const LAS bf16x8*)(cmrow + kk * 32), y, 0, 0, 0); }
                { const float el = vec[V_E / 4 + 32 * lt + r32];
#pragma unroll
                  for (int r = 0; r < 16; ++r) y[r] *= el; }
                const lptr xtrow = lds + O_XT + (32 * pt2 + r32) * PXT + hi * 8;
#pragma unroll
                for (int s_ = 0; s_ < 2; ++s_) if (s_ <= lt) {
#pragma unroll
                    for (int s2 = 0; s2 < 2; ++s2) { const u32x2 lo = *(const LAS u32x2*)(xtrow + (32 * s_ + 16 * s2) * 2), hi2 = *(const LAS u32x2*)(xtrow + (32 * s_ + 16 * s2 + 8) * 2);
                        u32x4 aw = {lo.x, lo.y, hi2.x, hi2.y};
                        y = __builtin_amdgcn_mfma_f32_32x32x16_bf16(*reinterpret_cast<bf16x8*>(&aw), gf[s_][s2], y, 0, 0, 0); }
                }
                float ss = 0.f;
                bf16* op = AM + (t0 + 32 * lt + r32) * KM + h * SSD_P + 32 * pt2 + 4 * hi;
#pragma unroll
                for (int q = 0; q < 4; ++q) { float o4[4];
#pragma unroll
                    for (int e = 0; e < 4; ++e) { const int p = 32 * pt2 + 8 * q + 4 * hi + e; const float xs = bf2f(*(const LAS bf16*)(lds + O_XT + p * PXT + (32 * lt + r32) * 2));
                        const float zv = (e & 1) ? bf_hi(e < 2 ? zr[q].x : zr[q].y) : bf_lo(e < 2 ? zr[q].x : zr[q].y);
                        const float ov = (y[4 * q + e] + dsk * xs) * silu_f(zv); o4[e] = ov; ss += ov * ov; }
                    u32x2 w; w.x = cvt_pk_bf16(o4[0], o4[1]); w.y = cvt_pk_bf16(o4[2], o4[3]); *(u32x2*)(op + 8 * q) = w; }
                ss += __shfl_xor(ss, 32);
                if (hi == 0) SSQ[(t0 + 32 * lt + r32) * 256 + h * 2 + pt2] = ss;
            }
            { const int nt = wid & 3, pt = wid >> 2; const float cdec = vec[V_E / 4 + 63];
#pragma unroll
              for (int r = 0; r < 16; ++r) st[r] *= cdec;
              const lptr btrow = lds + O_BT + (32 * nt + r32) * PBT + hi * 16; const lptr xtrow = lds + O_XT + (32 * pt + r32) * PXT + hi * 16;
#pragma unroll
              for (int ks = 0; ks < 4; ++ks) { const u32x4 xr = *(const LAS u32x4*)(xtrow + ks * 32);
                  const f32x4 w0 = *(const LAS f32x4*)(vec + V_W / 4 + 16 * ks + 8 * hi), w1 = *(const LAS f32x4*)(vec + V_W / 4 + 16 * ks + 8 * hi + 4);
                  float xv[8]; unpack8(xr, xv);
#pragma unroll
                  for (int e = 0; e < 4; ++e) { xv[e] *= w0[e]; xv[4 + e] *= w1[e]; }
                  st = __builtin_amdgcn_mfma_f32_32x32x16_bf16(*(const LAS bf16x8*)(btrow + ks * 32), pack8f(xv), st, 0, 0, 0); } }
            LDS_WAIT(); __syncthreads();
        }
    }
}
}

namespace fox {
constexpr float SCALE = 0.08838834764831845f;
constexpr int NW = 8, QBLK = 32, KVBLK = 64, QB = NW * QBLK, D = 128;
constexpr int SHM_V = KVBLK * D * 2, SHM_K = KVBLK * D * 2;
constexpr int OFF_WS = 2 * SHM_V + 2 * SHM_K, OFF_BL = OFF_WS + NW * 64 * 4, OFF_PREF = OFF_BL + SEQ * 4, ATTN_LDS = OFF_PREF + 256;
constexpr float THR = 8.f;
typedef short s16x4 __attribute__((ext_vector_type(4)));
typedef float f32x16 __attribute__((ext_vector_type(16)));
typedef LAS char* lptr;
#define KSWZ(row, colB) ((row) * 256 + ((colB) ^ (((row) & 7) << 4)))
#define SBAR() __builtin_amdgcn_sched_barrier(0)
__device__ __forceinline__ int v_st(int k, int c) { const int kk = (k & ~0xC) | ((k & 4) << 1) | ((k & 8) >> 1); return ((kk >> 3) * 4 + (c >> 5)) * 512 + ((kk & 7) * 32 + (c & 31)) * 2; }
__device__ __forceinline__ int v_rd_base(int lane) { return ((lane & 3) << 3) | (((lane >> 2) & 3) << 6) | (((lane >> 4) & 1) << 5) | (((lane >> 5) & 1) << 8); }
constexpr int v_rd_off(int d0, int ks, int half) { return d0 * 512 + ks * 4096 + half * 2048; }
__device__ __forceinline__ int crow(int r, int hi) { return (r & 3) + 8 * (r >> 2) + 4 * hi; }
__device__ __forceinline__ bf16x8 ld8(const bf16* p) { return *reinterpret_cast<const bf16x8*>(p); }
__device__ __forceinline__ void mask_tile(f32x16& p0, f32x16& p1, int dq) {
    const float NEG = -__builtin_inff();
#pragma unroll
    for (int r = 0; r < 16; ++r) { const int c = (r & 3) + 8 * (r >> 2); if (dq - c < 0) p0[r] = NEG; if (dq - c - 32 < 0) p1[r] = NEG; }
}
__device__ __forceinline__ void partialSM(f32x16& p0, f32x16& p1, float& m_reg, float& mn, float& alpha) {
    float pmax = p0[0];
#pragma unroll
    for (int r = 1; r < 16; ++r) pmax = fmaxf(pmax, p0[r]);
#pragma unroll
    for (int r = 0; r < 16; ++r) pmax = fmaxf(pmax, p1[r]);
    { auto rr = __builtin_amdgcn_permlane32_swap(__float_as_uint(pmax), __float_as_uint(pmax), false, false); pmax = fmaxf(__uint_as_float(rr[0]), __uint_as_float(rr[1])); }
    constexpr float C2 = 1.4426950408889634f * SCALE;
    if (__builtin_expect(__all((pmax - m_reg) * SCALE <= THR), 1)) { mn = m_reg; alpha = 1.f; }
    else { mn = fmaxf(m_reg, pmax); alpha = __builtin_amdgcn_exp2f((m_reg - mn) * C2); m_reg = mn; }
    const float mnL = -mn * C2;
#pragma unroll
    for (int r = 0; r < 16; ++r) p0[r] = fmaf(p0[r], C2, mnL);
#pragma unroll
    for (int r = 0; r < 16; ++r) p1[r] = fmaf(p1[r], C2, mnL);
#pragma unroll
    for (int r = 0; r < 16; ++r) p0[r] = __builtin_amdgcn_exp2f(p0[r]);
}
__device__ __forceinline__ void finishSM(f32x16& p0, f32x16& p1, float alpha, float& l_reg, bf16x8& pa0, bf16x8& pa1, bf16x8& pa2, bf16x8& pa3) {
#pragma unroll
    for (int r = 0; r < 16; ++r) p1[r] = __builtin_amdgcn_exp2f(p1[r]);
    float ps = 0;
#pragma unroll
    for (int r = 0; r < 16; ++r) ps += p0[r];
#pragma unroll
    for (int r = 0; r < 16; ++r) ps += p1[r];
    { auto rr = __builtin_amdgcn_permlane32_swap(__float_as_uint(ps), __float_as_uint(ps), false, false); ps = __uint_as_float(rr[0]) + __uint_as_float(rr[1]); }
    l_reg = l_reg * alpha + ps;
#define PK4(P, B_, OUT) do { unsigned a0 = cvt_pk_bf16(P[B_+0], P[B_+1]), a1 = cvt_pk_bf16(P[B_+2], P[B_+3]);                          \
        unsigned b0 = cvt_pk_bf16(P[B_+4], P[B_+5]), b1 = cvt_pk_bf16(P[B_+6], P[B_+7]);                                             \
        auto r0 = __builtin_amdgcn_permlane32_swap(a0, b0, false, false); auto r1 = __builtin_amdgcn_permlane32_swap(a1, b1, false, false); \
        u32x4 w = {r0[0], r1[0], r0[1], r1[1]}; OUT = *reinterpret_cast<bf16x8*>(&w); } while (0)
    PK4(p0, 0, pa0); PK4(p0, 8, pa1); PK4(p1, 0, pa2); PK4(p1, 8, pa3);
#undef PK4
}
template <int KB>
__device__ __forceinline__ void qkt(f32x16& p0, f32x16& p1, lptr K_lds, int r32, int hi, const bf16x8* qr, const LAS float* blk) {
    { const LAS f32x4* bp = (const LAS f32x4*)blk;
      const f32x4 a0 = bp[0], a1 = bp[2], a2 = bp[4], a3 = bp[6], c0 = bp[8], c1 = bp[10], c2 = bp[12], c3 = bp[14];
      p0 = (f32x16){a0[0], a0[1], a0[2], a0[3], a1[0], a1[1], a1[2], a1[3], a2[0], a2[1], a2[2], a2[3], a3[0], a3[1], a3[2], a3[3]};
      p1 = (f32x16){c0[0], c0[1], c0[2], c0[3], c1[0], c1[1], c1[2], c1[3], c2[0], c2[1], c2[2], c2[3], c3[0], c3[1], c3[2], c3[3]}; }
    lptr kb[4];
#pragma unroll
    for (int dd = 0; dd < 4; ++dd) kb[dd] = K_lds + KB * SHM_K + KSWZ(r32, (dd * 16 + hi * 8) * 2);
#pragma unroll
    for (int d0 = 0; d0 < 8; ++d0) { lptr a = kb[d0 & 3] + (d0 >> 2) * 128;
        bf16x8 b0 = *(const LAS bf16x8*)(a);
        bf16x8 b1 = *(const LAS bf16x8*)(a + 32 * 256);
        p0 = __builtin_amdgcn_mfma_f32_32x32x16_bf16(b0, qr[d0], p0, 0, 0, 0);
        p1 = __builtin_amdgcn_mfma_f32_32x32x16_bf16(b1, qr[d0], p1, 0, 0, 0); }
}
template <int VB>
__device__ __forceinline__ void pv_tile(f32x16* o, int vb0, bf16x8 pa0, bf16x8 pa1, bf16x8 pa2, bf16x8 pa3) {
#define TRRD(dst, off) asm volatile("ds_read_b64_tr_b16 %0, %1 offset:%2" : "=&v"(dst) : "v"(vb0), "i"(off) : "memory")
#define PV_D0(d0) do { s16x4 l0, l1, l2, l3, h0, h1, h2, h3; constexpr int b_ = VB * SHM_V + v_rd_off(d0, 0, 0); \
        TRRD(l0, b_); TRRD(h0, b_ + 2048); TRRD(l1, b_ + 4096); TRRD(h1, b_ + 6144); TRRD(l2, b_ + 8192); TRRD(h2, b_ + 10240); TRRD(l3, b_ + 12288); TRRD(h3, b_ + 14336); \
        asm volatile("s_waitcnt lgkmcnt(0)" ::: "memory"); SBAR();   \
        o[d0] = __builtin_amdgcn_mfma_f32_32x32x16_bf16(pa0, (bf16x8){l0[0], l0[1], l0[2], l0[3], h0[0], h0[1], h0[2], h0[3]}, o[d0], 0, 0, 0);   \
        o[d0] = __builtin_amdgcn_mfma_f32_32x32x16_bf16(pa1, (bf16x8){l1[0], l1[1], l1[2], l1[3], h1[0], h1[1], h1[2], h1[3]}, o[d0], 0, 0, 0);   \
        o[d0] = __builtin_amdgcn_mfma_f32_32x32x16_bf16(pa2, (bf16x8){l2[0], l2[1], l2[2], l2[3], h2[0], h2[1], h2[2], h2[3]}, o[d0], 0, 0, 0);   \
        o[d0] = __builtin_amdgcn_mfma_f32_32x32x16_bf16(pa3, (bf16x8){l3[0], l3[1], l3[2], l3[3], h3[0], h3[1], h3[2], h3[3]}, o[d0], 0, 0, 0); } while (0)
    PV_D0(0); PV_D0(1); PV_D0(2); PV_D0(3);
#undef PV_D0
#undef TRRD
}
struct BlockRef { const bf16* Q; const bf16* K; const bf16* V; bf16* O; int P0; };
struct Seam { bf16x8 qr[8]; bf16x8 st_v0, st_v1, st_k0, st_k1; };
#define ROWB(p, k0, half) ((const char*)((p) + (size_t)(k0) * LDP) + ((half) ? voff1 : voff0))
#define VMW() asm volatile("s_waitcnt vmcnt(0)" ::: "memory")
#define VMWN(n) asm volatile("s_waitcnt vmcnt(%0)" :: "i"(n) : "memory")
#define SLOAD_H(Kp, Vp, k0) do { S.st_v0 = ld8((const bf16*)ROWB(Vp, k0, 0)); S.st_v1 = ld8((const bf16*)ROWB(Vp, k0, 1)); S.st_k0 = ld8((const bf16*)ROWB(Kp, k0, 0)); S.st_k1 = ld8((const bf16*)ROWB(Kp, k0, 1)); } while (0)
#define SWRITE_HK(bf) do { *(LAS bf16x8*)(K_lds + (bf) * SHM_K + kws) = S.st_k0; *(LAS bf16x8*)(K_lds + (bf) * SHM_K + kws + 32 * 256) = S.st_k1; } while (0)
#define SWRITE_HV(bf) do { *(LAS bf16x8*)(V_lds + (bf) * SHM_V + vst0) = S.st_v0; *(LAS bf16x8*)(V_lds + (bf) * SHM_V + vst1) = S.st_v1; } while (0)
#define SWRITE_H(bf) do { SWRITE_HV(bf); SWRITE_HK(bf); } while (0)
__device__ __forceinline__ void prime(const BlockRef& cur, lptr lds, Seam& S) {
    const int tid = threadIdx.x, wid = __builtin_amdgcn_readfirstlane(tid >> 6), lane = tid & 63, r32 = lane & 31, hi = lane >> 5;
    const int sr = tid >> 4, sc = (tid & 15) * 8, kws = KSWZ(sr, sc * 2); lptr K_lds = lds + 2 * SHM_V;
    const unsigned voff0 = (unsigned)(sr * LDP + sc) * 2u, voff1 = voff0 + 32u * LDP * 2u;
#pragma unroll
    for (int d0 = 0; d0 < 8; ++d0) S.qr[d0] = ld8((const bf16*)((const char*)cur.Q + (unsigned)((wid * QBLK + r32) * LDP + hi * 8) * 2u + d0 * 32));
    SLOAD_H(cur.K, cur.V, 0); VMW(); SWRITE_HK(0);
    __syncthreads();
}
__device__ __forceinline__ void block(const BlockRef& cur, const BlockRef& nxt, lptr lds, Seam& S) {
    const int tid = threadIdx.x, wid = __builtin_amdgcn_readfirstlane(tid >> 6), lane = tid & 63, r32 = lane & 31, hi = lane >> 5;
    const int NT = (cur.P0 + QB) / KVBLK;
    const int qlo = cur.P0 + wid * QBLK, qm = qlo + r32 - 4 * hi;
    lptr V_lds = lds; lptr K_lds = lds + 2 * SHM_V;
    LAS float* ws = (LAS float*)(lds + OFF_WS) + wid * 64; LAS float* li_l = ws; LAS float* al_l = ws + 32;
    const LAS float* bl = (const LAS float*)(lds + OFF_BL) + 4 * hi;
    float m_reg = -1e30f, l_reg = 0; f32x16 o[4] = {};
    const int sr = tid >> 4, sc = (tid & 15) * 8, vst0 = v_st(sr, sc), vst1 = v_st(32 + sr, sc), kws = KSWZ(sr, sc * 2);
    const unsigned voff0 = (unsigned)(sr * LDP + sc) * 2u, voff1 = voff0 + 32u * LDP * 2u;
    const int vb0 = (int)(unsigned)(uintptr_t)V_lds + v_rd_base(lane);
    const bf16* Kh = cur.K; const bf16* Vh = cur.V;
#define RESC(a) do { if (__any((a) < 1.f)) { if (hi == 0) al_l[r32] = (a); asm volatile("s_waitcnt lgkmcnt(0)" ::: "memory");              \
                     for (int d_ = 0; d_ < 4; ++d_) for (int r = 0; r < 16; ++r) o[d_][r] *= al_l[crow(r, hi)]; } } while (0)
#define KBASE(t) ((t) * KVBLK)
#define MASKT(P0_, P1_, t) do { const int kb_ = KBASE(t); if (kb_ + KVBLK - 1 > qlo) mask_tile(P0_, P1_, qm - kb_); } while (0)
#define SEAM_K0() do { VMWN(8); SWRITE_HK(0); SBAR(); } while (0)
    f32x16 pA0, pA1, pB0, pB1; float mnA, mnB, alA, alB; bf16x8 pa0, pa1, pa2, pa3;
    SWRITE_HV(0); SBAR();
    if (NT > 1) SLOAD_H(Kh, Vh, KBASE(1));
    SBAR(); qkt<0>(pA0, pA1, K_lds, r32, hi, S.qr, bl + KBASE(0));
    MASKT(pA0, pA1, 0); partialSM(pA0, pA1, m_reg, mnA, alA);
    if (NT > 1) { VMW(); SWRITE_H(1); }
    __syncthreads();
#define HALF_STEP(PX0, PX1, mnX, alX, PY0, PY1, alY, t, KB, VB, SB) do {                                                      \
        SBAR(); qkt<KB>(PX0, PX1, K_lds, r32, hi, S.qr, bl + KBASE(t));                                                       \
        finishSM(PY0, PY1, alY, l_reg, pa0, pa1, pa2, pa3); SBAR();                                                           \
        if ((t) + 1 < NT) { SLOAD_H(Kh, Vh, KBASE((t) + 1)); SBAR(); }                                                        \
        pv_tile<VB>(o, vb0, pa0, pa1, pa2, pa3); MASKT(PX0, PX1, (t)); partialSM(PX0, PX1, m_reg, mnX, alX);                  \
        __syncthreads();                                                                                                      \
        if ((t) + 1 < NT) { VMW(); SWRITE_H(SB); }                                                                            \
        RESC(alX); __syncthreads(); } while (0)
    for (int t = 1; t + 1 < NT; t += 2) {
        HALF_STEP(pB0, pB1, mnB, alB, pA0, pA1, alA, t, 1, 0, 0);
        HALF_STEP(pA0, pA1, mnA, alA, pB0, pB1, alB, t + 1, 0, 1, 1);
    }
    SBAR(); qkt<1>(pB0, pB1, K_lds, r32, hi, S.qr, bl + KBASE(NT - 1)); SBAR();
    SLOAD_H(nxt.K, nxt.V, 0); SBAR();
#pragma unroll
    for (int d0 = 0; d0 < 8; ++d0) S.qr[d0] = ld8((const bf16*)((const char*)nxt.Q + (unsigned)((wid * QBLK + r32) * LDP + hi * 8) * 2u + d0 * 32));
    SBAR();
    finishSM(pA0, pA1, alA, l_reg, pa0, pa1, pa2, pa3); SBAR();
    pv_tile<0>(o, vb0, pa0, pa1, pa2, pa3);
    MASKT(pB0, pB1, NT - 1); partialSM(pB0, pB1, m_reg, mnB, alB); __syncthreads(); RESC(alB);
    finishSM(pB0, pB1, alB, l_reg, pa0, pa1, pa2, pa3); SBAR(); pv_tile<1>(o, vb0, pa0, pa1, pa2, pa3);
    SBAR(); SEAM_K0();
    if (hi == 0) li_l[r32] = l_reg; asm volatile("s_waitcnt lgkmcnt(0)" ::: "memory");
    float rli[16];
#pragma unroll
    for (int r = 0; r < 16; ++r) rli[r] = __builtin_amdgcn_rcpf(li_l[crow(r, hi)]);
    bf16* Ow = cur.O + (size_t)(wid * QBLK) * KM;
#pragma unroll
    for (int r = 0; r < 16; ++r) { const int orow = crow(r, hi);
#pragma unroll
        for (int d0 = 0; d0 < 4; ++d0) { const float v = o[d0][r] * rli[r];
            const float vn = __shfl_xor(v, 1);
            if ((r32 & 1) == 0) *(unsigned*)(Ow + (size_t)orow * KM + d0 * 32 + r32) = cvt_pk_bf16(v, vn); } }
    __syncthreads();
#undef RESC
#undef KBASE
#undef MASKT
#undef SEAM_K0
#undef HALF_STEP
}
#undef ROWB
#undef VMW
#undef VMWN
#undef SLOAD_H
#undef SWRITE_HK
#undef SWRITE_HV
#undef SWRITE_H
struct Item { int bh, qb0, qb1; };
__device__ __forceinline__ Item decode(int L) { Item it; it.bh = L >> 3; const int x = L & 7; it.qb0 = x; it.qb1 = 15 - x; return it; }
__device__ __forceinline__ BlockRef ref(const Item& it, int pass, const bf16* PROJ, bf16* AM) {
    const int qb = pass ? it.qb1 : it.qb0, b = it.bh / FOX_H, h = it.bh % FOX_H; BlockRef r;
    const size_t row0 = (size_t)b * SEQ;
    r.Q = PROJ + (row0 + (size_t)qb * QB) * LDP + PQ + h * D; r.K = PROJ + row0 * LDP + PK + h * D; r.V = PROJ + row0 * LDP + PV + h * D;
    r.O = AM + (row0 + (size_t)qb * QB) * KM + D_INNER + h * D; r.P0 = qb * QB; return r;
}
__device__ __forceinline__ void build_bias(lptr lds, const float* LCh) {
    const LAS float* pref = (const LAS float*)(lds + OFF_PREF); LAS float* bl = (LAS float*)(lds + OFF_BL);
    int s0 = threadIdx.x * 8; asm volatile("" : "+v"(s0));
    const float fref = LCh[SEQ / 2 - 1] + pref[(SEQ / 2 - 1) >> 6]; const float pc = pref[s0 >> 6];
    const f32x4 a = *(const f32x4*)(LCh + s0), b = *(const f32x4*)(LCh + s0 + 4);
    constexpr float IS = 1.f / SCALE;
    *(LAS f32x4*)(bl + s0) = (fref - (a + pc)) * IS; *(LAS f32x4*)(bl + s0 + 4) = (fref - (b + pc)) * IS;
}
__device__ __forceinline__ void build_pref(lptr lds, const float* CTh) {
    int lane = threadIdx.x; asm volatile("" : "+v"(lane));
    if (lane < 64) { const float v = CTh[lane]; float inc = v;
#pragma unroll
        for (int o = 1; o < 64; o <<= 1) { const float u = __shfl_up(inc, o); if (lane >= o) inc += u; }
        ((LAS float*)(lds + OFF_PREF))[lane] = inc - v; }
}
__device__ __forceinline__ void phase(lptr lds, const bf16* PROJ, const float* LC, const float* CT, bf16* AM, int G, int bx) {
    const int total = 8 * BATCH * FOX_H, stride = G;
    int L = (G % 8 == 0) ? (bx % 8) * (G / 8) + bx / 8 : bx;
    if (L >= total) return;
    Item it = decode(L); int pass = 0;
    BlockRef cur = ref(it, 0, PROJ, AM);
    Seam S;
    build_pref(lds, CT + it.bh * 64); __syncthreads();
    build_bias(lds, LC + (size_t)it.bh * SEQ);
    prime(cur, lds, S);
    for (;;) {
        const bool more_pass = pass == 0, more_item = L + stride < total, last = !more_pass && !more_item;
        Item itn = it; int passn = pass + 1, Ln = L;
        if (!more_pass) { passn = 0; Ln = more_item ? L + stride : L; itn = decode(Ln); }
        const BlockRef nxt = last ? cur : ref(itn, passn, PROJ, AM);
        block(cur, nxt, lds, S);
        if (last) break;
        if (itn.bh != it.bh) { build_pref(lds, CT + itn.bh * 64); __syncthreads(); build_bias(lds, LC + (size_t)itn.bh * SEQ); __syncthreads(); }
        cur = nxt; it = itn; pass = passn; L = Ln;
    }
}
#undef KSWZ
#undef SBAR
}

enum { PH_PROLOGUE = 0, PH_INPROJ, PH_PREP, PH_SSD, PH_ATTN, PH_MERGE, PH_MIX, PH_LN1, PH_UP, PH_ACT, PH_DOWN, PH_LN2, PH_COUNT };
constexpr int TAB_OFF = RING_BYTES + 1024;
static_assert(TAB_OFF + 8192 <= LDS_BYTES && MISC_OFF + 128 <= TAB_OFF, "LDS map");

__global__ void __launch_bounds__(NWAVES * 64, 2) mk_fwd(Params p) {
    extern __shared__ __attribute__((aligned(16))) unsigned char lds_raw[];
    Frame F;
    F.lds = (LAS unsigned char*)lds_raw;
    volatile LAS unsigned* MISC = (volatile LAS unsigned*)(F.lds + MISC_OFF);
    F.tid = threadIdx.x; F.lane = F.tid & 63; F.wave = __builtin_amdgcn_readfirstlane(F.tid >> 6);
    F.G = gridDim.x; F.gw = blockIdx.x * NWAVES + F.wave; F.ngw = F.G * NWAVES;
    F.x = p.in[0]; F.w_in = p.in[1]; F.conv_w = p.in[2]; F.conv_b = p.in[3]; F.dt_bias = p.in[4]; F.a_log = p.in[5]; F.ssd_d = p.in[6]; F.norm_w = p.in[7]; F.f_bias = p.in[8]; F.gate_bias = p.in[9];
    F.w_pssd = p.in[10]; F.w_patt = p.in[11]; F.w_out = p.in[12]; F.ln1_g = p.in[13]; F.ln1_b = p.in[14]; F.w_up = p.in[15]; F.fconv_w = p.in[16]; F.fconv_b = p.in[17]; F.w_down = p.in[18]; F.ln2_g = p.in[19]; F.ln2_b = p.in[20];
    F.out = p.out;
    unsigned char* ws = p.ws;
    F.XB = (bf16*)(ws + WS_XB); F.WIN = (bf16*)(ws + WS_WIN); F.WP = (bf16*)(ws + WS_WP); F.WO = (bf16*)(ws + WS_WO); F.WUP = (bf16*)(ws + WS_WUP); F.WD = (bf16*)(ws + WS_WD);
    F.PROJ = (bf16*)(ws + WS_PROJ); F.XACT = (bf16*)(ws + WS_XACT); F.AM = (bf16*)(ws + WS_AM); F.MG = (bf16*)(ws + WS_MG); F.H1B = (bf16*)(ws + WS_H1B); F.U = (bf16*)(ws + WS_U); F.ACT = (bf16*)(ws + WS_ACT);
    F.DTF = (float*)(ws + WS_DTF); F.DTV = (float*)(ws + WS_DTV); F.LC = (float*)(ws + WS_LC); F.CT = (float*)(ws + WS_CT); F.SSQ = (float*)(ws + WS_SSQ); F.RT = (float*)(ws + WS_CT + 512 * 1024); F.M1 = (float*)(ws + WS_M1); F.H1 = (float*)(ws + WS_H1);
    for (int u = F.tid; u < (LDS_BYTES - RING_BYTES) / 4; u += NWAVES * 64) ((LAS unsigned*)(F.lds + RING_BYTES))[u] = 0u;
    __syncthreads();
    const int lo = p.ph_lo, hi = p.ph_hi;
    XcdBarrier bar; bar.bar = (unsigned*)(ws + WS_CTL) + CW_BAR; bar.x = 0; bar.st = nullptr;
    if (hi - lo > 1) bar = xcd_barrier_post((unsigned*)(ws + WS_CTL) + CW_BAR, MISC + 8);
#define IN(k) (lo <= (k) && (k) < hi)
#define SEAM(k) do { if (IN(k) && IN((k) + 1)) xcd_barrier(bar); } while (0)

    if (IN(PH_PROLOGUE)) { p0_prologue(F); } SEAM(PH_PROLOGUE);

    if (IN(PH_INPROJ)) {
        { pg8::Gemm g{F.XB, F.WIN, D_MODEL, D_MODEL, D_MODEL}; pg8::StaticOrder S; S.init(T, LDP, F.G, (int)blockIdx.x, D_MODEL); pg8::EpiStoreBf16 E{F.PROJ, LDP};
          pg8::gemm_phase<pg8::EpiStoreBf16, pg8::StaticOrder, true>(F.lds, g, S, E); }
        { pg8::Gemm g{F.XB, F.WIN + (size_t)PSMALL * D_MODEL, D_MODEL, D_MODEL, KSLAB}; pg8::SplitKOrder S{T / 256, NSLAB, KSLAB, F.G, (int)blockIdx.x}; pg8::EpiSlabF32 E{F.DTF, KSLAB, (size_t)T * 256};
          pg8::gemm_phase<pg8::EpiSlabF32, pg8::SplitKOrder, false>(F.lds, g, S, E); }
    } SEAM(PH_INPROJ);

    if (IN(PH_PREP)) { p2_prep(F); } SEAM(PH_PREP);

    if (IN(PH_SSD)) { ssd::phase((ssd::lptr)F.lds, F.PROJ, F.XACT, F.DTV, F.a_log, F.ssd_d, F.AM, F.SSQ, F.G, (int)blockIdx.x); } SEAM(PH_SSD);

    if (IN(PH_ATTN)) { rt_rows(F); fox::phase((fox::lptr)F.lds, F.PROJ, F.LC, F.CT, F.AM, F.G, (int)blockIdx.x); } SEAM(PH_ATTN);

    if (IN(PH_MERGE)) { pg8::Gemm g{F.AM, F.WP, KM, KM, KM}; pg8::StaticOrder S; S.init(T, D_MODEL, F.G, (int)blockIdx.x, KM);
        pg8::EpiMerge E{F.PROJ, F.gate_bias + D_MODEL, F.MG}; pg8::MergeHook H{(LAS float*)(F.lds + TAB_OFF), F.RT, F.PROJ, F.gate_bias};
        pg8::gemm_phase<pg8::EpiMerge, pg8::StaticOrder, true, pg8::MergeHook>(F.lds, g, S, E, H); } SEAM(PH_MERGE);

    if (IN(PH_MIX)) { pg8::Gemm g{F.MG, F.WO, D_MODEL, D_MODEL, D_MODEL}; pg8::StaticOrder S; S.init(T, D_MODEL, F.G, (int)blockIdx.x, D_MODEL); pg8::EpiResid E{F.x, F.M1};
        pg8::gemm_phase<pg8::EpiResid, pg8::StaticOrder, true>(F.lds, g, S, E); } SEAM(PH_MIX);

    if (IN(PH_LN1)) { ln_rows<true>(F, F.M1, F.ln1_g, F.ln1_b, F.H1, F.H1B); } SEAM(PH_LN1);

    if (IN(PH_UP)) { pg8::Gemm g{F.H1B, F.WUP, D_MODEL, D_MODEL, D_MODEL}; pg8::StaticOrder S; S.init(T, 2 * D_FF, F.G, (int)blockIdx.x, D_MODEL); pg8::EpiStoreBf16 E{F.U, 2 * D_FF};
        pg8::gemm_phase<pg8::EpiStoreBf16, pg8::StaticOrder, true>(F.lds, g, S, E); } SEAM(PH_UP);

    if (IN(PH_ACT)) { constexpr int N_ACT = (T / 16) * 43; for (int it = F.gw; it < N_ACT; it += F.ngw) p11_act_item(F, it); } SEAM(PH_ACT);

    if (IN(PH_DOWN)) { pg8::Gemm g{F.ACT, F.WD, D_FF, D_FF, D_FF}; pg8::StaticOrder S; S.init(T, D_MODEL, F.G, (int)blockIdx.x, D_FF); pg8::EpiResid E{F.H1, F.M1};
        pg8::gemm_phase<pg8::EpiResid, pg8::StaticOrder, true>(F.lds, g, S, E); } SEAM(PH_DOWN);

    if (IN(PH_LN2)) { ln_rows<false>(F, F.M1, F.ln2_g, F.ln2_b, F.out, nullptr); }
#undef IN
#undef SEAM
}

extern "C" void kernel_launch(void* const* d_in, const int* in_sizes, int n_in, void* d_out, int out_size, void* d_ws, size_t ws_size, hipStream_t stream) {
    static int grid = 0;
    if (grid == 0) {
        if (n_in != 21 || in_sizes[0] != T * D_MODEL || out_size != T * D_MODEL || ws_size < WS_END) { fprintf(stderr, "kernel_launch: unexpected shapes (n_in %d, in0 %d, out %d, ws %zu < %zu); nothing launched\n", n_in, n_in > 0 ? in_sizes[0] : -1, out_size, ws_size, (size_t)WS_END); grid = -1; return; }
        int dev = 0, cus = 0, per_cu = 0;
        if (hipGetDevice(&dev) != hipSuccess || hipDeviceGetAttribute(&cus, hipDeviceAttributeMultiprocessorCount, dev) != hipSuccess) { grid = -1; return; }
        if (hipFuncSetAttribute((const void*)mk_fwd, hipFuncAttributeMaxDynamicSharedMemorySize, LDS_BYTES) != hipSuccess) { fprintf(stderr, "kernel_launch: hipFuncSetAttribute failed\n"); grid = -1; return; }
        if (hipOccupancyMaxActiveBlocksPerMultiprocessor(&per_cu, (const void*)mk_fwd, NWAVES * 64, LDS_BYTES) != hipSuccess || per_cu < 1) fprintf(stderr, "kernel_launch: note: occupancy query reports %d workgroups per CU\n", per_cu);
        (void)hipGetLastError();
        grid = cus;
    }
    if (grid < 0) return;
    (void)hipMemsetAsync((char*)d_ws + WS_CTL, 0, CTL_ZERO_BYTES, stream);
    Params p{};
    for (int i = 0; i < 21; ++i) p.in[i] = (const float*)d_in[i];
    p.out = (float*)d_out; p.ws = (unsigned char*)d_ws;
#if MK_ONE_LAUNCH
    p.ph_lo = 0; p.ph_hi = PH_COUNT;
    hipLaunchKernelGGL(mk_fwd, dim3(grid), dim3(NWAVES * 64), LDS_BYTES, stream, p);
#else
    for (int ph = 0; ph < PH_COUNT; ++ph) {
        p.ph_lo = ph; p.ph_hi = ph + 1;
        hipLaunchKernelGGL(mk_fwd, dim3(grid), dim3(NWAVES * 64), LDS_BYTES, stream, p);
    }
#endif
}
```
